# Optimizing an MI355X kernel written in HIP

```python
import math
import jax, jax.numpy as jnp
from jax import lax
import numpy as np

D_MODEL = 1024
BATCH = 16
SEQ = 2048
DEPTH = 1

HEAD_DIM = 64
NSA_HEADS = 8
NSA_KV_GROUPS = 2
NSA_Q_PER_GROUP = NSA_HEADS // NSA_KV_GROUPS
CMP_BLOCK = 32
CMP_STRIDE = 16
CMP_HIDDEN = 128
SLC_BLOCK = 64
SLC_TOPK = 8
WINDOW = 512
FOX_HEADS = 8
Q_BLOCK = 128
D_FF = 2816
N_BUCKETS = 32
MAX_DISTANCE = 128
RMS_EPS = 1e-6
NEG_INF = -1.0e30
FORCE_BONUS = 1.0e4

NSA_W = NSA_HEADS * HEAD_DIM
NSA_KV_W = NSA_KV_GROUPS * HEAD_DIM
FOX_W = FOX_HEADS * HEAD_DIM
IN_SPLITS = (NSA_W, NSA_KV_W, NSA_KV_W, NSA_KV_W, NSA_KV_W, NSA_KV_W, NSA_KV_W, 3 * NSA_HEADS,
             FOX_W, FOX_W, FOX_W, FOX_HEADS, 2 * D_MODEL)
D_IN = sum(IN_SPLITS)

kernel_name = 'hybrid_nsa_fox_macaron'


def _rms(x, g):
    xf = x.astype(jnp.float32)
    y = xf * lax.rsqrt(jnp.mean(xf * xf, axis=-1, keepdims=True) + RMS_EPS)
    return (y * g.astype(jnp.float32)).astype(x.dtype)


def _swiglu(x, w_up, w_down):
    gate, up = jnp.split(x @ w_up, 2, axis=-1)
    return (jax.nn.silu(gate) * up) @ w_down


def _t5_bucket(dist):
    n = jnp.maximum(dist, 0)
    max_exact = N_BUCKETS // 2
    nf = jnp.maximum(n, 1).astype(jnp.float32)
    large = max_exact + (jnp.log(nf / max_exact) / math.log(MAX_DISTANCE / max_exact)
                         * (N_BUCKETS - max_exact)).astype(jnp.int32)
    large = jnp.minimum(large, N_BUCKETS - 1)
    return jnp.where(n < max_exact, n, large)


def _masked_softmax(logits, mask):
    p = jax.nn.softmax(jnp.where(mask, logits, NEG_INF), axis=-1)
    return p * mask


def _compress(kv, pos, w1, w2):
    B, S, G, dh = kv.shape
    nc = (S - CMP_BLOCK) // CMP_STRIDE + 1
    idx = np.arange(nc)[:, None] * CMP_STRIDE + np.arange(CMP_BLOCK)[None, :]
    blocks = kv[:, idx] + pos[None, None, :, None, :]
    blocks = blocks.transpose(0, 3, 1, 2, 4).reshape(B, G, nc, CMP_BLOCK * dh)
    return jax.nn.silu(blocks @ w1) @ w2


def _hybrid_layer(x, ffn1_norm, ffn1_w_up, ffn1_w_down, mix_norm, w_in, b_forget, nsa_q_gain, nsa_k_gain,
                  fox_q_gain, fox_k_gain, cmp_pos_k, cmp_pos_v, cmp_k_w1, cmp_k_w2, cmp_v_w1, cmp_v_w2,
                  w_o_nsa, w_o_fox, w_out, ffn2_norm, ffn2_w_up, ffn2_w_down, rel_bias_table):
    B, S, D = x.shape
    G, R, H, dh, HB = NSA_KV_GROUPS, NSA_Q_PER_GROUP, NSA_HEADS, HEAD_DIM, FOX_HEADS
    nq = S // Q_BLOCK
    scale = 1.0 / math.sqrt(dh)
    f32 = jnp.float32
    t_pos = jnp.arange(S)
    starts = jnp.arange(nq) * Q_BLOCK

    x = x + 0.5 * _swiglu(_rms(x, ffn1_norm), ffn1_w_up, ffn1_w_down)

    u = _rms(x, mix_norm)
    split_pts = np.cumsum(np.array(IN_SPLITS))[:-1].tolist()
    qa, kc, vc, ks, vs, kw, vw, ga, qb, kb, vb, fb, gm = jnp.split(u @ w_in, split_pts, axis=-1)

    qa = _rms(qa.reshape(B, S, H, dh), nsa_q_gain) * scale
    qa = qa.reshape(B, S, G, R, dh).transpose(0, 2, 3, 1, 4)
    kc = _rms(_compress(kc.reshape(B, S, G, dh), cmp_pos_k, cmp_k_w1, cmp_k_w2), nsa_k_gain[0])
    vc = _compress(vc.reshape(B, S, G, dh), cmp_pos_v, cmp_v_w1, cmp_v_w2)
    ks = _rms(ks.reshape(B, S, G, dh), nsa_k_gain[1]).transpose(0, 2, 1, 3)
    vs = vs.reshape(B, S, G, dh).transpose(0, 2, 1, 3)
    kw = _rms(kw.reshape(B, S, G, dh), nsa_k_gain[2]).transpose(0, 2, 1, 3)
    vw = vw.reshape(B, S, G, dh).transpose(0, 2, 1, 3)

    dist_bias = rel_bias_table[_t5_bucket(t_pos)].T.reshape(G, R, S).astype(f32)

    nc = kc.shape[2]
    cmp_end = jnp.arange(nc) * CMP_STRIDE + CMP_BLOCK - 1
    dist_c = t_pos[:, None] - cmp_end[None, :]
    logit_c = (jnp.einsum('bgrsd,bgcd->bgrsc', qa, kc).astype(f32)
               + dist_bias[:, :, jnp.clip(dist_c, 0, S - 1)])
    p_c = _masked_softmax(logit_c, dist_c >= 0)
    o_cmp = jnp.einsum('bgrsc,bgcd->bgrsd', p_c.astype(vc.dtype), vc)

    ns = S // SLC_BLOCK
    ci = np.arange(nc)[:, None] * CMP_STRIDE
    sj = np.arange(ns)[None, :] * SLC_BLOCK
    overlap = ((ci <= sj + SLC_BLOCK - 1) & (ci + CMP_BLOCK - 1 >= sj)).astype(np.float32)
    imp = jnp.einsum('bgrsc,cj->bgsj', p_c, jnp.asarray(overlap))
    cur = t_pos // SLC_BLOCK
    blk = jnp.arange(ns)
    forced = (blk[None, :] == 0) | (blk[None, :] == cur[:, None]) | (blk[None, :] == cur[:, None] - 1)
    imp = jnp.where(blk[None, :] <= cur[:, None], imp + FORCE_BONUS * forced, NEG_INF)
    n_sel = min(SLC_TOPK, ns)
    _, sel_idx = lax.top_k(imp, n_sel)

    ks_blk = ks.reshape(B, G, ns, SLC_BLOCK, dh)
    vs_blk = vs.reshape(B, G, ns, SLC_BLOCK, dh)
    kw_pad = jnp.pad(kw, ((0, 0), (0, 0), (WINDOW, 0), (0, 0)))
    vw_pad = jnp.pad(vw, ((0, 0), (0, 0), (WINDOW, 0), (0, 0)))
    q_chunks = qa.reshape(B, G, R, nq, Q_BLOCK, dh).transpose(3, 0, 1, 2, 4, 5)
    idx_chunks = sel_idx.reshape(B, G, nq, Q_BLOCK, n_sel).transpose(2, 0, 1, 3, 4)
    bi = jnp.arange(B)[:, None, None, None]
    gi = jnp.arange(G)[None, :, None, None]
    n_keys = n_sel * SLC_BLOCK

    def nsa_block(args):
        q, idx, start = args
        t = start + jnp.arange(Q_BLOCK)
        k_sel = ks_blk[bi, gi, idx]
        v_sel = vs_blk[bi, gi, idx]
        tok = idx[..., None] * SLC_BLOCK + jnp.arange(SLC_BLOCK)
        dist = t[None, None, :, None, None] - tok
        bias = jax.vmap(lambda tab, d: tab[:, d], in_axes=(0, 1), out_axes=0)(
            dist_bias, jnp.clip(dist, 0, S - 1))
        bias = bias.transpose(2, 0, 1, 3, 4, 5)
        logit = jnp.einsum('bgrtd,bgtnld->bgrtnl', q, k_sel).astype(f32) + bias
        logit = logit.reshape(B, G, R, Q_BLOCK, n_keys)
        mask = (dist >= 0).reshape(B, G, 1, Q_BLOCK, n_keys)
        p = _masked_softmax(logit, mask)
        o_s = jnp.einsum('bgrtk,bgtkd->bgrtd', p.astype(v_sel.dtype),
                         v_sel.reshape(B, G, Q_BLOCK, n_keys, dh))
        k_win = lax.dynamic_slice_in_dim(kw_pad, start, WINDOW + Q_BLOCK, axis=2)
        v_win = lax.dynamic_slice_in_dim(vw_pad, start, WINDOW + Q_BLOCK, axis=2)
        s_pos = start - WINDOW + jnp.arange(WINDOW + Q_BLOCK)
        dist_w = t[:, None] - s_pos[None, :]
        mask_w = (dist_w >= 0) & (dist_w < WINDOW) & (s_pos[None, :] >= 0)
        logit_w = (jnp.einsum('bgrtd,bgsd->bgrts', q, k_win).astype(f32)
                   + dist_bias[:, :, jnp.clip(dist_w, 0, S - 1)])
        p_w = _masked_softmax(logit_w, mask_w)
        o_w = jnp.einsum('bgrts,bgsd->bgrtd', p_w.astype(v_win.dtype), v_win)
        return o_s, o_w

    o_slc, o_win = lax.map(nsa_block, (q_chunks, idx_chunks, starts))
    o_slc = o_slc.transpose(1, 0, 4, 2, 3, 5).reshape(B, S, H, dh)
    o_win = o_win.transpose(1, 0, 4, 2, 3, 5).reshape(B, S, H, dh)
    o_cmp = o_cmp.transpose(0, 3, 1, 2, 4).reshape(B, S, H, dh)
    g_nsa = jax.nn.sigmoid(ga).reshape(B, S, 3, H)[..., None]
    o_nsa = (g_nsa[:, :, 0] * o_cmp + g_nsa[:, :, 1] * o_slc + g_nsa[:, :, 2] * o_win).reshape(B, S, NSA_W)

    qb = (_rms(qb.reshape(B, S, HB, dh), fox_q_gain) * scale).transpose(0, 2, 1, 3)
    kb = _rms(kb.reshape(B, S, HB, dh), fox_k_gain).transpose(0, 2, 1, 3)
    vb = vb.reshape(B, S, HB, dh).transpose(0, 2, 1, 3)
    log_f = jax.nn.log_sigmoid((fb + b_forget).astype(f32))
    cum = jnp.cumsum(log_f, axis=1).transpose(0, 2, 1)
    qb_chunks = qb.reshape(B, HB, nq, Q_BLOCK, dh).transpose(2, 0, 1, 3, 4)
    cum_chunks = cum.reshape(B, HB, nq, Q_BLOCK).transpose(2, 0, 1, 3)

    def fox_block(args):
        q, cq, start = args
        t = start + jnp.arange(Q_BLOCK)
        logit = (jnp.einsum('bhtd,bhsd->bhts', q, kb).astype(f32)
                 + cq[..., None] - cum[:, :, None, :])
        p = _masked_softmax(logit, t_pos[None, :] <= t[:, None])
        return jnp.einsum('bhts,bhsd->bhtd', p.astype(vb.dtype), vb)

    o_fox = lax.map(fox_block, (qb_chunks, cum_chunks, starts))
    o_fox = o_fox.transpose(1, 0, 3, 2, 4).reshape(B, S, FOX_W)

    gate_a, gate_b = jnp.split(jax.nn.sigmoid(gm), 2, axis=-1)
    merged = gate_a * (o_nsa @ w_o_nsa) + gate_b * (o_fox @ w_o_fox)
    x = x + merged @ w_out

    x = x + 0.5 * _swiglu(_rms(x, ffn2_norm), ffn2_w_up, ffn2_w_down)
    return x


def setup_inputs(seed: int = 0) -> dict:
    key = jax.random.key(seed)
    ks = jax.random.split(key, 24)
    f32 = jnp.float32
    L = DEPTH

    def nrm(k, shape, fan_in):
        return jax.random.normal(k, shape, f32) * (fan_in ** -0.5)

    def gain(k, shape):
        return 1.0 + 0.1 * jax.random.normal(k, shape, f32)

    return {
        'x': jax.random.normal(ks[0], (BATCH, SEQ, D_MODEL), f32),
        'ffn1_norm': gain(ks[1], (L, D_MODEL)),
        'ffn1_w_up': nrm(ks[2], (L, D_MODEL, 2 * D_FF), D_MODEL),
        'ffn1_w_down': nrm(ks[3], (L, D_FF, D_MODEL), D_FF),
        'mix_norm': gain(ks[4], (L, D_MODEL)),
        'w_in': nrm(ks[5], (L, D_MODEL, D_IN), D_MODEL),
        'b_forget': jax.random.uniform(ks[6], (L, FOX_HEADS), f32, 1.0, 5.0),
        'nsa_q_gain': gain(ks[7], (L, HEAD_DIM)),
        'nsa_k_gain': gain(ks[8], (L, 3, HEAD_DIM)),
        'fox_q_gain': gain(ks[9], (L, HEAD_DIM)),
        'fox_k_gain': gain(ks[10], (L, HEAD_DIM)),
        'cmp_pos_k': 0.1 * jax.random.normal(ks[11], (L, CMP_BLOCK, HEAD_DIM), f32),
        'cmp_pos_v': 0.1 * jax.random.normal(ks[12], (L, CMP_BLOCK, HEAD_DIM), f32),
        'cmp_k_w1': nrm(ks[13], (L, CMP_BLOCK * HEAD_DIM, CMP_HIDDEN), CMP_BLOCK * HEAD_DIM),
        'cmp_k_w2': nrm(ks[14], (L, CMP_HIDDEN, HEAD_DIM), CMP_HIDDEN),
        'cmp_v_w1': nrm(ks[15], (L, CMP_BLOCK * HEAD_DIM, CMP_HIDDEN), CMP_BLOCK * HEAD_DIM),
        'cmp_v_w2': nrm(ks[16], (L, CMP_HIDDEN, HEAD_DIM), CMP_HIDDEN),
        'w_o_nsa': nrm(ks[17], (L, NSA_W, D_MODEL), NSA_W),
        'w_o_fox': nrm(ks[18], (L, FOX_W, D_MODEL), FOX_W),
        'w_out': nrm(ks[19], (L, D_MODEL, D_MODEL), D_MODEL),
        'ffn2_norm': gain(ks[20], (L, D_MODEL)),
        'ffn2_w_up': nrm(ks[21], (L, D_MODEL, 2 * D_FF), D_MODEL),
        'ffn2_w_down': nrm(ks[22], (L, D_FF, D_MODEL), D_FF),
        'rel_bias_table': 0.5 * jax.random.normal(ks[23], (N_BUCKETS, NSA_HEADS), f32),
    }


def reference(x, ffn1_norm, ffn1_w_up, ffn1_w_down, mix_norm, w_in, b_forget, nsa_q_gain, nsa_k_gain,
              fox_q_gain, fox_k_gain, cmp_pos_k, cmp_pos_v, cmp_k_w1, cmp_k_w2, cmp_v_w1, cmp_v_w2,
              w_o_nsa, w_o_fox, w_out, ffn2_norm, ffn2_w_up, ffn2_w_down, rel_bias_table):
    for layer in range(DEPTH):
        x = _hybrid_layer(x, ffn1_norm[layer], ffn1_w_up[layer], ffn1_w_down[layer], mix_norm[layer],
                          w_in[layer], b_forget[layer], nsa_q_gain[layer], nsa_k_gain[layer],
                          fox_q_gain[layer], fox_k_gain[layer], cmp_pos_k[layer], cmp_pos_v[layer],
                          cmp_k_w1[layer], cmp_k_w2[layer], cmp_v_w1[layer], cmp_v_w2[layer],
                          w_o_nsa[layer], w_o_fox[layer], w_out[layer], ffn2_norm[layer],
                          ffn2_w_up[layer], ffn2_w_down[layer], rel_bias_table)
    return x
```

```cpp
#include <hip/hip_runtime.h>
#include <hip/hip_cooperative_groups.h>
#include <cstdio>
#include <cstdint>
namespace cg = cooperative_groups;

namespace pg8 {
#define PG8_LAS __attribute__((address_space(3)))
typedef unsigned short bf16_t;
typedef short bf16x8 __attribute__((ext_vector_type(8)));
typedef float f32x4 __attribute__((ext_vector_type(4)));
typedef unsigned u32x4 __attribute__((ext_vector_type(4)));
constexpr int BM = 256, BK = 64, HALF = 128, HTB = HALF * BK * 2  , STAGE_BYTES = 8 * HTB, NXCD = 8, WGM = 8;

__host__ __device__ __forceinline__ int lds_byte(int r, int c) { const int st = (r >> 4) * 2 + (c >> 5), rr = r & 15, cc = c & 31, ob = rr * 64 + cc * 2; return st * 1024 + (ob ^ (((ob >> 9) & 1) << 5)); }
__host__ __device__ __forceinline__ void stage_rc(int b, int& R, int& C) { const int st = b / 1024, sb = b % 1024, swz = sb ^ (((sb >> 9) & 1) << 5); R = (st >> 1) * 16 + swz / 64; C = (st & 1) * 32 + (swz % 64) / 2; }
__host__ __device__ __forceinline__ int perm32(int rho) { const int n = rho >> 4, i = rho & 15; return 8 * (i >> 2) + 4 * n + (i & 3); }

struct Unit { int pm, pn; };
struct Gemm { const bf16_t* A; const bf16_t* Bt; int M, N, K; };

struct StaticOrder {
    int nM, nN, nwg, G, c;
    __host__ __device__ void init(int M, int N, int G_, int c_) { nM = M / BM; nN = N / BM; nwg = nM * nN; G = G_; c = c_; }
    __host__ __device__ bool next(int i, Unit& u) const {
        const long L = (long)i * G + c; if (L >= nwg) return false;
        int wgid = (int)L; { const int q = nwg / NXCD, r = nwg % NXCD, xcd = wgid % NXCD, off = wgid / NXCD; wgid = (xcd < r ? xcd * (q + 1) : r * (q + 1) + (xcd - r) * q) + off; }
        const int nig = WGM * nN, gid = wgid / nig, fm = gid * WGM, gsz = (nM - fm) < WGM ? (nM - fm) : WGM;
        u.pm = fm + ((wgid % nig) % gsz); u.pn = (wgid % nig) / gsz; return true;
    }
    __device__ __forceinline__ void a_ready(const Unit&) const {}
    __device__ __forceinline__ void done(const Unit&) const {}
};

typedef float f32x2 __attribute__((ext_vector_type(2)));
typedef __bf16 bf16x2_t __attribute__((ext_vector_type(2)));
typedef unsigned u32x2 __attribute__((ext_vector_type(2)));
__device__ __forceinline__ unsigned cvt_pk_bf16(float lo, float hi) { f32x2 v = {lo, hi}; bf16x2_t b = __builtin_convertvector(v, bf16x2_t); return __builtin_bit_cast(unsigned, b); }
__device__ __forceinline__ float bf_lo(unsigned w) { return __uint_as_float(w << 16); }
__device__ __forceinline__ float bf_hi(unsigned w) { return __uint_as_float(w & 0xffff0000u); }
constexpr float LOG2E = 1.4426950408889634f;
__device__ __forceinline__ float fast_sigmoid(float x) { return __builtin_amdgcn_rcpf(1.0f + __builtin_amdgcn_exp2f(-x * LOG2E)); }
__device__ __forceinline__ float silu_f(float x) { return x * fast_sigmoid(x); }
constexpr float RMS_EPS = 1e-6f;
__device__ __forceinline__ float row_rinv(const float* ssq, int row, int fq) {
    const f32x4 p = *(const f32x4*)(ssq + (size_t)row * 16 + 4 * fq);
    float s = (p[0] + p[1]) + (p[2] + p[3]);
    s += __shfl_xor(s, 16); s += __shfl_xor(s, 32);
    return __builtin_amdgcn_rsqf(s * (1.0f / 1024.0f) + RMS_EPS);
}

struct EpiSwiGLU {
    static constexpr bool PERM = true, AFTER_DRAIN = false;
    bf16_t* H; int ldh; const float* ssq;
    __device__ __forceinline__ void operator()(const f32x4 (&acc)[2][2][4][2], const Unit& u, int wr, int wc, int fr, int fq) const {
        const int row0 = u.pm * BM + wr * 64 + fr, col0 = u.pn * HALF + wc * 32 + 8 * fq;
#pragma unroll
        for (int ai = 0; ai < 2; ++ai)
#pragma unroll
            for (int m = 0; m < 4; ++m) { const int row = row0 + ai * HALF + m * 16; const float rs = row_rinv(ssq, row, fq);
                float o[8];
#pragma unroll
                for (int n = 0; n < 2; ++n)
#pragma unroll
                    for (int i = 0; i < 4; ++i) { const float g = acc[ai][0][m][n][i] * rs, up = acc[ai][1][m][n][i] * rs; o[4 * n + i] = silu_f(g) * up; }
                u32x4 w; w.x = cvt_pk_bf16(o[0], o[1]); w.y = cvt_pk_bf16(o[2], o[3]); w.z = cvt_pk_bf16(o[4], o[5]); w.w = cvt_pk_bf16(o[6], o[7]);
                *(u32x4*)(H + (size_t)row * ldh + col0) = w; }
    }
};

struct EpiResid {
    static constexpr bool PERM = false, AFTER_DRAIN = false;
    const float* base; float* out; float alpha; bf16_t* xb; float* ssq;
    __device__ __forceinline__ void operator()(const f32x4 (&acc)[2][2][4][2], const Unit& u, int wr, int wc, int fr, int fq) const {
        const int row0 = u.pm * BM + wr * 64 + fr, col0 = u.pn * BM + wc * 32 + 4 * fq;
#pragma unroll
        for (int ai = 0; ai < 2; ++ai)
#pragma unroll
            for (int m = 0; m < 4; ++m) { const int row = row0 + ai * HALF + m * 16; const size_t off = (size_t)row * 1024 + col0; float ss = 0.f;
#pragma unroll
                for (int bj = 0; bj < 2; ++bj)
#pragma unroll
                    for (int n = 0; n < 2; ++n) { const f32x4 bs = *(const f32x4*)(base + off + bj * HALF + n * 16); const f32x4 v = bs + acc[ai][bj][m][n] * alpha;
                        *(f32x4*)(out + off + bj * HALF + n * 16) = v; ss += (v[0] * v[0] + v[1] * v[1]) + (v[2] * v[2] + v[3] * v[3]);
                        if (xb) { u32x2 w; w.x = cvt_pk_bf16(v[0], v[1]); w.y = cvt_pk_bf16(v[2], v[3]); *(u32x2*)(xb + off + bj * HALF + n * 16) = w; } }
                if (ssq) { ss += __shfl_xor(ss, 16); ss += __shfl_xor(ss, 32); if (fq == 0) ssq[(size_t)row * 16 + 4 * u.pn + wc] = ss; } }
    }
};

struct EpiGate {
    static constexpr bool PERM = true, AFTER_DRAIN = false;
    bf16_t* T; const bf16_t* gate; int goff; bool first;
    __device__ __forceinline__ void operator()(const f32x4 (&acc)[2][2][4][2], const Unit& u, int wr, int wc, int fr, int fq) const {
        const int row0 = u.pm * BM + wr * 64 + fr, col0 = u.pn * BM + wc * 32 + 8 * fq;
#pragma unroll
        for (int ai = 0; ai < 2; ++ai)
#pragma unroll
            for (int m = 0; m < 4; ++m) { const int row = row0 + ai * HALF + m * 16;
#pragma unroll
                for (int bj = 0; bj < 2; ++bj) { const int c = col0 + bj * HALF;
                    const u32x4 gw = *(const u32x4*)(gate + (size_t)row * 2048 + goff + c);
                    float o[8];
#pragma unroll
                    for (int q = 0; q < 4; ++q) { o[2 * q] = bf_lo(gw[q]) * acc[ai][bj][m][q >> 1][(2 * q) & 3]; o[2 * q + 1] = bf_hi(gw[q]) * acc[ai][bj][m][q >> 1][(2 * q + 1) & 3]; }
                    if (!first) { const u32x4 tw = *(const u32x4*)(T + (size_t)row * 1024 + c);
#pragma unroll
                        for (int q = 0; q < 4; ++q) { o[2 * q] += bf_lo(tw[q]); o[2 * q + 1] += bf_hi(tw[q]); } }
                    u32x4 w; w.x = cvt_pk_bf16(o[0], o[1]); w.y = cvt_pk_bf16(o[2], o[3]); w.z = cvt_pk_bf16(o[4], o[5]); w.w = cvt_pk_bf16(o[6], o[7]);
                    *(u32x4*)(T + (size_t)row * 1024 + c) = w; } }
    }
};

struct ProjOut { bf16_t *QA, *KC, *VC, *KS, *VS, *KW, *VW, *QB, *KB, *VB, *GM; float *GA, *LF; };
constexpr float QSCALE = 0.125f * LOG2E;
struct EpiProj {
    static constexpr bool PERM = true, AFTER_DRAIN = false;
    ProjOut P; const float* ssq; const float *nsa_q_gain, *nsa_k_gain, *fox_q_gain, *fox_k_gain, *b_forget;
    __device__ __forceinline__ void operator()(const f32x4 (&acc)[2][2][4][2], const Unit& u, int wr, int wc, int fr, int fq) const {
        const int row0 = u.pm * BM + wr * 64 + fr; const int pn = u.pn;
        if (pn == 19) {
            if (wc != 0) return;
            f32x4 bfv[2]; bfv[0] = *(const f32x4*)(b_forget); bfv[1] = *(const f32x4*)(b_forget + 4);
#pragma unroll
            for (int ai = 0; ai < 2; ++ai)
#pragma unroll
                for (int m = 0; m < 4; ++m) { const int row = row0 + ai * HALF + m * 16; const float rs = row_rinv(ssq, row, fq);
#pragma unroll
                    for (int n = 0; n < 2; ++n) { const f32x4 v = acc[ai][0][m][n] * rs; f32x4 o;
                        if (fq < 3) {
#pragma unroll
                            for (int i = 0; i < 4; ++i) o[i] = 1.0f / (1.0f + __expf(-v[i]));
                            *(f32x4*)(P.GA + (size_t)row * 24 + 8 * fq + 4 * n) = o;
                        } else {
#pragma unroll
                            for (int i = 0; i < 4; ++i) { const float x = v[i] + bfv[n][i]; o[i] = fminf(x, 0.f) - log1pf(__expf(-fabsf(x))); }
                            *(f32x4*)(P.LF + (size_t)row * 8 + 4 * n) = o;
                        } } }
            return;
        }
        int kind = 0; const float* gain = nullptr; float mul = 1.f; bf16_t* dst = nullptr; int pitch = 128;
        if (pn < 2) { kind = 1; gain = nsa_q_gain; mul = QSCALE; dst = P.QA + 256 * pn + 64 * wc; pitch = 512; }
        else if (pn == 2) { dst = (wc < 2) ? P.KC + 64 * wc : P.VC + 64 * (wc - 2); }
        else if (pn == 3) { if (wc < 2) { kind = 1; gain = nsa_k_gain + 64; dst = P.KS + 64 * wc; } else dst = P.VS + 64 * (wc - 2); }
        else if (pn == 4) { if (wc < 2) { kind = 1; gain = nsa_k_gain + 128; dst = P.KW + 64 * wc; } else dst = P.VW + 64 * (wc - 2); }
        else if (pn < 7) { kind = 1; gain = fox_q_gain; mul = QSCALE; dst = P.QB + 256 * (pn - 5) + 64 * wc; pitch = 512; }
        else if (pn < 9) { kind = 1; gain = fox_k_gain; dst = P.KB + 256 * (pn - 7) + 64 * wc; pitch = 512; }
        else if (pn < 11) { dst = P.VB + 256 * (pn - 9) + 64 * wc; pitch = 512; }
        else { kind = 2; dst = P.GM + 256 * (pn - 11) + 64 * wc; pitch = 2048; }
#pragma unroll
        for (int ai = 0; ai < 2; ++ai)
#pragma unroll
            for (int m = 0; m < 4; ++m) { const int row = row0 + ai * HALF + m * 16; const float rs = row_rinv(ssq, row, fq);
                float hs = rs;
                if (kind == 1) { float ss = 0.f;
#pragma unroll
                    for (int bj = 0; bj < 2; ++bj)
#pragma unroll
                        for (int n = 0; n < 2; ++n) { const f32x4 v = acc[ai][bj][m][n] * rs; ss += (v[0] * v[0] + v[1] * v[1]) + (v[2] * v[2] + v[3] * v[3]); }
                    ss += __shfl_xor(ss, 16); ss += __shfl_xor(ss, 32); hs = rs * __builtin_amdgcn_rsqf(ss * (1.0f / 64.0f) + RMS_EPS) * mul; }
#pragma unroll
                for (int bj = 0; bj < 2; ++bj) { float o[8];
#pragma unroll
                    for (int n = 0; n < 2; ++n) { f32x4 gvn = {1.f, 1.f, 1.f, 1.f}; if (kind == 1) gvn = *(const f32x4*)(gain + 32 * bj + 8 * fq + 4 * n);
#pragma unroll
                        for (int i = 0; i < 4; ++i) { float x = acc[ai][bj][m][n][i] * hs; if (kind == 2) x = fast_sigmoid(x); else x = x * gvn[i]; o[4 * n + i] = x; } }
                    u32x4 w; w.x = cvt_pk_bf16(o[0], o[1]); w.y = cvt_pk_bf16(o[2], o[3]); w.z = cvt_pk_bf16(o[4], o[5]); w.w = cvt_pk_bf16(o[6], o[7]);
                    *(u32x4*)(dst + (size_t)row * pitch + 32 * bj + 8 * fq) = w; } }
    }
};

template <class Epi, class Sched, bool ALIGN_EPI = false, bool SP2 = false>
__device__ __forceinline__ void gemm_phase(PG8_LAS unsigned char* lds, const Gemm g, const Sched& S, const Epi& E, int tid_in) {
    int tid_ = tid_in; asm volatile("" : "+v"(tid_));
    const int tid = tid_, wid = __builtin_amdgcn_readfirstlane(tid >> 6), lane = tid & 63, wr = wid >> 2, wc = wid & 3, fr = lane & 15, fq = lane >> 4;
    const int K = g.K, nt = K / BK;
    unsigned voffA[2], voffB[2];
#pragma unroll
    for (int i = 0; i < 2; ++i) { int R, C; stage_rc(tid * 16 + i * 8192, R, C); const int Rb = Epi::PERM ? ((R & ~31) + perm32(R & 31)) : R;
        voffA[i] = (unsigned)(R * K + C) * 2u; voffB[i] = (unsigned)(Rb * K + C) * 2u; }
    const size_t kstep = (size_t)(BK * 2);
    const size_t hstep = (size_t)HALF * K * 2;
    const size_t tstep = 2 * hstep;
    const unsigned ldsw = (unsigned)wid * 1024u;
    const int aoff = lds_byte(wr * 64 + fr, fq * 8), boff = lds_byte(wc * 32 + fr, fq * 8);
#define PG8_SA(b, h) (((b) * 2 + (h)) * HTB)
#define PG8_SB(b, h) ((4 + (b) * 2 + (h)) * HTB)
#define PG8_STAGE(bufoff, gbase, voff) do { _Pragma("unroll") for (int _i = 0; _i < 2; ++_i) \
        __builtin_amdgcn_global_load_lds((const unsigned*)((const char*)(gbase) + (voff)[_i]), (PG8_LAS unsigned*)(lds + (bufoff) + ldsw + _i * 8192), 16, 0, 0); } while (0)
#define PG8_LDA(dst, b, h) do { _Pragma("unroll") for (int m = 0; m < 4; ++m) _Pragma("unroll") for (int k = 0; k < 2; ++k) dst[m][k] = *(const PG8_LAS bf16x8*)(lds + PG8_SA(b, h) + aoff + m * 2048 + k * 1024); } while (0)
#define PG8_LDB(dst, b, h) do { _Pragma("unroll") for (int n = 0; n < 2; ++n) _Pragma("unroll") for (int k = 0; k < 2; ++k) dst[n][k] = *(const PG8_LAS bf16x8*)(lds + PG8_SB(b, h) + boff + n * 2048 + k * 1024); } while (0)
#define PG8_MMA(ai, bj, At, Bt) do { __builtin_amdgcn_s_setprio(1); _Pragma("unroll") for (int m = 0; m < 4; ++m) _Pragma("unroll") for (int n = 0; n < 2; ++n) _Pragma("unroll") for (int k = 0; k < 2; ++k) \
        acc[ai][bj][m][n] = __builtin_amdgcn_mfma_f32_16x16x32_bf16(Bt[n][k], At[m][k], acc[ai][bj][m][n], 0, 0, 0); __builtin_amdgcn_s_setprio(0); } while (0)
#define PG8_WAIT_V(n) asm volatile("s_waitcnt vmcnt(" #n ")" ::: "memory")
#define PG8_WAIT_L(n) asm volatile("s_waitcnt lgkmcnt(" #n ")" ::: "memory")
#define PG8_BAR __builtin_amdgcn_s_barrier()
#define PG8_SCHED __builtin_amdgcn_sched_barrier(0)
    Unit cur, nxt; int ui = 0;
    if (!S.next(0, cur)) return;
    f32x4 acc[2][2][4][2];
#pragma unroll
    for (int a = 0; a < 2; ++a)
#pragma unroll
        for (int b = 0; b < 2; ++b)
#pragma unroll
            for (int m = 0; m < 4; ++m)
#pragma unroll
                for (int n = 0; n < 2; ++n) acc[a][b][m][n] = (f32x4){0.f, 0.f, 0.f, 0.f};
    bf16x8 At[4][2], B0[2][2], B1[2][2];
    const char* cA = (const char*)g.A + (size_t)cur.pm * tstep; const char* cB = (const char*)g.Bt + (size_t)cur.pn * tstep;
    S.a_ready(cur);
    if constexpr (SP2) {
        PG8_STAGE(PG8_SB(0, 0), cB, voffB); PG8_STAGE(PG8_SB(0, 1), cB + hstep, voffB); PG8_STAGE(PG8_SA(0, 0), cA, voffA); PG8_STAGE(PG8_SA(0, 1), cA + hstep, voffA);
        if (wr == 1) PG8_BAR;
        PG8_WAIT_V(2); PG8_BAR;
        PG8_STAGE(PG8_SB(1, 0), cB + kstep, voffB); PG8_STAGE(PG8_SA(1, 0), cA + kstep, voffA); PG8_STAGE(PG8_SB(1, 1), cB + hstep + kstep, voffB);
        PG8_WAIT_V(6); PG8_BAR;
    } else {
        PG8_STAGE(PG8_SB(0, 0), cB, voffB); PG8_STAGE(PG8_SA(0, 0), cA, voffA); PG8_STAGE(PG8_SB(0, 1), cB + hstep, voffB); PG8_STAGE(PG8_SA(0, 1), cA + hstep, voffA);
        if (wr == 1) PG8_BAR;
        PG8_WAIT_V(4); PG8_BAR;
        PG8_STAGE(PG8_SB(1, 0), cB + kstep, voffB); PG8_STAGE(PG8_SA(1, 0), cA + kstep, voffA); PG8_STAGE(PG8_SB(1, 1), cB + hstep + kstep, voffB);
        PG8_WAIT_V(6); PG8_BAR;
    }
    for (;;) {
        const bool has_next = S.next(ui + 1, nxt);
        const char* nA = has_next ? (const char*)g.A + (size_t)nxt.pm * tstep : cA; const char* nB = has_next ? (const char*)g.Bt + (size_t)nxt.pn * tstep : cB;
        for (int t = 0; t < nt; t += 2) {
            const bool last = (t == nt - 2);
            const char* a1 = cA + (size_t)(t + 1) * kstep;
            const char* a2 = last ? nA : cA + (size_t)(t + 2) * kstep; const char* b2 = last ? nB : cB + (size_t)(t + 2) * kstep;
            const char* a3 = a2 + kstep; const char* b3 = b2 + kstep;
            if (last && has_next) S.a_ready(nxt);
            if constexpr (SP2) {
            PG8_LDB(B0, 0, 0); PG8_LDB(B1, 0, 1); PG8_SCHED; PG8_LDA(At, 0, 0); PG8_STAGE(PG8_SA(1, 1), a1 + hstep, voffA);
            PG8_WAIT_V(8); PG8_WAIT_L(0); PG8_BAR; PG8_MMA(0, 0, At, B0); PG8_MMA(0, 1, At, B1); PG8_BAR; PG8_SCHED;
            PG8_LDA(At, 0, 1); PG8_STAGE(PG8_SB(0, 0), b2, voffB); PG8_STAGE(PG8_SB(0, 1), b2 + hstep, voffB); PG8_STAGE(PG8_SA(0, 0), a2, voffA);
            PG8_WAIT_V(8); PG8_WAIT_L(0); PG8_BAR; PG8_MMA(1, 0, At, B0); PG8_MMA(1, 1, At, B1); PG8_BAR; PG8_SCHED;
            PG8_LDB(B0, 1, 0); PG8_LDB(B1, 1, 1); PG8_SCHED; PG8_LDA(At, 1, 0); PG8_STAGE(PG8_SA(0, 1), a2 + hstep, voffA);
            PG8_WAIT_V(8); PG8_WAIT_L(0); PG8_BAR; PG8_MMA(0, 0, At, B0); PG8_MMA(0, 1, At, B1); PG8_BAR; PG8_SCHED;
            PG8_LDA(At, 1, 1); PG8_STAGE(PG8_SB(1, 0), b3, voffB); PG8_STAGE(PG8_SB(1, 1), b3 + hstep, voffB); PG8_STAGE(PG8_SA(1, 0), a3, voffA);
            PG8_WAIT_V(8); PG8_WAIT_L(0); PG8_BAR; PG8_MMA(1, 0, At, B0); PG8_MMA(1, 1, At, B1); PG8_BAR; PG8_SCHED;
            } else {
            PG8_LDB(B0, 0, 0); PG8_SCHED; PG8_LDA(At, 0, 0); PG8_STAGE(PG8_SA(1, 1), a1 + hstep, voffA);
            PG8_WAIT_L(8); PG8_BAR; PG8_WAIT_L(0); PG8_MMA(0, 0, At, B0); PG8_BAR; PG8_SCHED;
            PG8_LDB(B1, 0, 1); PG8_STAGE(PG8_SB(0, 0), b2, voffB);
            PG8_BAR; PG8_WAIT_L(0); PG8_MMA(0, 1, At, B1); PG8_BAR;
            PG8_LDA(At, 0, 1); PG8_STAGE(PG8_SA(0, 0), a2, voffA);
            PG8_BAR; PG8_WAIT_L(0); PG8_MMA(1, 0, At, B0); PG8_BAR; PG8_SCHED;
            PG8_STAGE(PG8_SB(0, 1), b2 + hstep, voffB);
            PG8_WAIT_V(6); PG8_BAR; PG8_MMA(1, 1, At, B1); PG8_BAR;
            PG8_LDB(B0, 1, 0); PG8_SCHED; PG8_LDA(At, 1, 0); PG8_STAGE(PG8_SA(0, 1), a2 + hstep, voffA);
            PG8_WAIT_L(8); PG8_BAR; PG8_WAIT_L(0); PG8_MMA(0, 0, At, B0); PG8_BAR; PG8_SCHED;
            PG8_LDB(B1, 1, 1); PG8_STAGE(PG8_SB(1, 0), b3, voffB);
            PG8_BAR; PG8_WAIT_L(0); PG8_MMA(0, 1, At, B1); PG8_BAR;
            PG8_LDA(At, 1, 1); PG8_STAGE(PG8_SA(1, 0), a3, voffA);
            PG8_BAR; PG8_WAIT_L(0); PG8_MMA(1, 0, At, B0); PG8_BAR; PG8_SCHED;
            PG8_STAGE(PG8_SB(1, 1), b3 + hstep, voffB);
            PG8_WAIT_V(6); PG8_BAR; PG8_MMA(1, 1, At, B1); PG8_BAR;
            }
        }
        if constexpr (ALIGN_EPI) { if (wr == 0) PG8_BAR; }
        if constexpr (!Epi::AFTER_DRAIN) { E(acc, cur, wr, wc, fr, fq); S.done(cur); }
        if (!has_next) break;
#pragma unroll
        for (int a = 0; a < 2; ++a)
#pragma unroll
            for (int b = 0; b < 2; ++b)
#pragma unroll
                for (int m = 0; m < 4; ++m)
#pragma unroll
                    for (int n = 0; n < 2; ++n) acc[a][b][m][n] = (f32x4){0.f, 0.f, 0.f, 0.f};
        cur = nxt; cA = nA; cB = nB; ++ui;
        if constexpr (ALIGN_EPI) { if (wr == 1) PG8_BAR; }
    }
    PG8_WAIT_V(0);
    if constexpr (!ALIGN_EPI) { if (wr == 0) PG8_BAR; }
    PG8_BAR;
    if constexpr (Epi::AFTER_DRAIN) { E.fused(acc, cur, wr, wc, fr, fq, lds, wid, lane); S.done(cur); }
#undef PG8_SA
#undef PG8_SB
#undef PG8_STAGE
#undef PG8_LDA
#undef PG8_LDB
#undef PG8_MMA
#undef PG8_WAIT_V
#undef PG8_WAIT_L
#undef PG8_BAR
#undef PG8_SCHED
}
}

constexpr int BATCH = 16, SEQ = 2048, DM = 1024, MTOK = BATCH * SEQ, DFF = 2816, NUP = 2 * DFF, D_IN = 4896, NIN = 5120;
constexpr int NWAVES = 8, NTHREADS = 512;
#define LAS __attribute__((address_space(3)))
typedef pg8::bf16_t bf16_t;
typedef short bf16x8 __attribute__((ext_vector_type(8)));
typedef float f32x4 __attribute__((ext_vector_type(4)));
typedef float f32x16 __attribute__((ext_vector_type(16)));
typedef unsigned u32x4 __attribute__((ext_vector_type(4)));
typedef unsigned u32x2 __attribute__((ext_vector_type(2)));
typedef short s16x4 __attribute__((ext_vector_type(4)));
using pg8::cvt_pk_bf16; using pg8::LOG2E; using pg8::RMS_EPS;

constexpr size_t MiB = 1u << 20, KiB = 1u << 10;
constexpr size_t WS_WUP1 = 1 * MiB, WS_WDN1 = 12 * MiB, WS_WIN = 18 * MiB, WS_WON = 28 * MiB, WS_WOF = 29 * MiB, WS_WOUT = 30 * MiB, WS_WUP2 = 32 * MiB, WS_WDN2 = 43 * MiB;
constexpr size_t WS_CW1K = 49 * MiB, WS_CW1V = 49 * MiB + 512 * KiB, WS_CW2K = 50 * MiB, WS_CW2V = 50 * MiB + 64 * KiB, WS_TAB = 50 * MiB + 128 * KiB, WS_C1 = 50 * MiB + 192 * KiB;
constexpr size_t WS_KCMP = 51 * MiB, WS_VCMP = 51 * MiB + 512 * KiB, WS_SSQ = 52 * MiB, WS_GA = 54 * MiB, WS_LF = 57 * MiB;
constexpr size_t WS_XB = 58 * MiB;
constexpr size_t WS_A = 122 * MiB;
constexpr size_t A_QA = 0, A_KC = 32 * MiB, A_VC = 40 * MiB, A_KS = 48 * MiB, A_VS = 56 * MiB, A_KW = 64 * MiB, A_VW = 72 * MiB, A_QB = 80 * MiB, A_KB = 112 * MiB, A_VB = 144 * MiB, A_GM = 176 * MiB;
constexpr size_t WS_END = 426 * MiB;
constexpr int LDS_BYTES = 147456;

__constant__ unsigned char T5_BUCKET[128] = {0, 1, 2, 3, 4, 5, 6, 7, 8, 9, 10, 11, 12, 13, 14, 15, 16, 16, 16, 17, 17, 18, 18, 18, 19, 19, 19, 20, 20, 20, 20, 21, 21, 21, 21, 22, 22, 22, 22, 22, 23, 23, 23, 23, 23, 23, 24, 24, 24, 24, 24, 24, 25, 25, 25, 25, 25, 25, 25, 26, 26, 26, 26, 26, 26, 26, 26, 27, 27, 27, 27, 27, 27, 27, 27, 27, 27, 28, 28, 28, 28, 28, 28, 28, 28, 28, 28, 29, 29, 29, 29, 29, 29, 29, 29, 29, 29, 29, 29, 30, 30, 30, 30, 30, 30, 30, 30, 30, 30, 30, 30, 30, 30, 31, 31, 31, 31, 31, 31, 31, 31, 31, 31, 31, 31, 31, 31, 31};

struct Args { const float* in[24]; float* out; unsigned char* ws; int ph_lo, ph_hi; };

#define LDS_WAIT() asm volatile("s_waitcnt lgkmcnt(0)" ::: "memory")
__device__ __forceinline__ float wave_sum(float v) {
#pragma unroll
    for (int o = 1; o < 64; o <<= 1) v += __shfl_xor(v, o);
    return v;
}

template <int MODE> __device__ __forceinline__ int src_col(int n) {
    if (MODE == 0) return n;
    if (MODE == 1) { const int pn = n >> 8, bj = (n >> 7) & 1, q = n & 127; return bj * DFF + 128 * pn + q; }
    const int pn = n >> 8, bj = (n >> 7) & 1, wc = (n >> 5) & 3, j = n & 31, L = 256 * pn + 64 * wc + 32 * bj + j;
    if (L < 1280) return L;
    if (L < 2816) return 1304 + (L - 1280);
    if (L < 4864) return 2848 + (L - 2816);
    if (L < 4888) return 1280 + (L - 4864);
    if (L < 4896) return 2840 + (L - 4888);
    return -1;
}
template <int MODE> __device__ __forceinline__ void transpose_item(const float* W, int ldw, int K, int N, const float* ks, bf16_t* WT, LAS float* scr, int item, int lane) {
    const int nblk = N / 32, kb = item / nblk, nb = item % nblk, k0 = 64 * kb, n0 = 32 * nb;
    const int sc = src_col<MODE>(n0 + (lane & 31));
#pragma unroll 8
    for (int i = 0; i < 32; ++i) { const int kk = 2 * i + (lane >> 5); float v = 0.f; if (sc >= 0) v = W[(size_t)(k0 + kk) * ldw + sc]; if (ks) v *= ks[k0 + kk]; scr[kk * 33 + (lane & 31)] = v; }
    LDS_WAIT(); asm volatile("" ::: "memory");
    const int c = lane & 7;
#pragma unroll
    for (int j = 0; j < 4; ++j) { const int n = (lane >> 3) + 8 * j; const LAS float* s = scr + (8 * c) * 33 + n;
        u32x4 o; o.x = cvt_pk_bf16(s[0 * 33], s[1 * 33]); o.y = cvt_pk_bf16(s[2 * 33], s[3 * 33]); o.z = cvt_pk_bf16(s[4 * 33], s[5 * 33]); o.w = cvt_pk_bf16(s[6 * 33], s[7 * 33]);
        *(u32x4*)(WT + (size_t)(n0 + n) * K + k0 + 8 * c) = o; }
    LDS_WAIT(); asm volatile("" ::: "memory");
}

__device__ __forceinline__ void prep_phase(const Args& a, LAS unsigned char* lds, int vcu, int G, int wave, int lane) {
    unsigned char* ws = a.ws;
    LAS float* scr = (LAS float*)(lds + wave * 16384);
    const int gw = vcu * NWAVES + wave, NGW = G * NWAVES;
    constexpr int I_UP = (DM / 64) * (NUP / 32), I_DN = (DFF / 64) * (DM / 32), I_IN = (DM / 64) * (NIN / 32), I_O = (512 / 64) * (DM / 32), I_OUT = (DM / 64) * (DM / 32), I_C1 = (2048 / 64) * (128 / 32), I_C2 = (128 / 64) * (64 / 32);
    constexpr int NITEMS = 2 * I_UP + 2 * I_DN + I_IN + 2 * I_O + I_OUT + 2 * I_C1 + 2 * I_C2;
    for (int it = gw; it < NITEMS; it += NGW) {
        int r = it;
        if (r < I_UP) { transpose_item<1>(a.in[2], NUP, DM, NUP, a.in[1], (bf16_t*)(ws + WS_WUP1), scr, r, lane); continue; } r -= I_UP;
        if (r < I_UP) { transpose_item<1>(a.in[21], NUP, DM, NUP, a.in[20], (bf16_t*)(ws + WS_WUP2), scr, r, lane); continue; } r -= I_UP;
        if (r < I_DN) { transpose_item<0>(a.in[3], DM, DFF, DM, nullptr, (bf16_t*)(ws + WS_WDN1), scr, r, lane); continue; } r -= I_DN;
        if (r < I_DN) { transpose_item<0>(a.in[22], DM, DFF, DM, nullptr, (bf16_t*)(ws + WS_WDN2), scr, r, lane); continue; } r -= I_DN;
        if (r < I_IN) { transpose_item<2>(a.in[5], D_IN, DM, NIN, a.in[4], (bf16_t*)(ws + WS_WIN), scr, r, lane); continue; } r -= I_IN;
        if (r < I_O) { transpose_item<0>(a.in[17], DM, 512, DM, nullptr, (bf16_t*)(ws + WS_WON), scr, r, lane); continue; } r -= I_O;
        if (r < I_O) { transpose_item<0>(a.in[18], DM, 512, DM, nullptr, (bf16_t*)(ws + WS_WOF), scr, r, lane); continue; } r -= I_O;
        if (r < I_OUT) { transpose_item<0>(a.in[19], DM, DM, DM, nullptr, (bf16_t*)(ws + WS_WOUT), scr, r, lane); continue; } r -= I_OUT;
        if (r < I_C1) { transpose_item<0>(a.in[13], 128, 2048, 128, nullptr, (bf16_t*)(ws + WS_CW1K), scr, r, lane); continue; } r -= I_C1;
        if (r < I_C1) { transpose_item<0>(a.in[15], 128, 2048, 128, nullptr, (bf16_t*)(ws + WS_CW1V), scr, r, lane); continue; } r -= I_C1;
        if (r < I_C2) { transpose_item<0>(a.in[14], 64, 128, 64, nullptr, (bf16_t*)(ws + WS_CW2K), scr, r, lane); continue; } r -= I_C2;
        transpose_item<0>(a.in[16], 64, 128, 64, nullptr, (bf16_t*)(ws + WS_CW2V), scr, r, lane);
    }
    const float* x = a.in[0]; bf16_t* XB = (bf16_t*)(ws + WS_XB); float* SSQ = (float*)(ws + WS_SSQ);
    for (int m = gw; m < MTOK; m += NGW) {
        const f32x4* xr = (const f32x4*)(x + (size_t)m * DM) + lane; f32x4 v[4]; float s = 0.f;
#pragma unroll
        for (int j = 0; j < 4; ++j) { v[j] = xr[64 * j]; s += (v[j][0] * v[j][0] + v[j][1] * v[j][1]) + (v[j][2] * v[j][2] + v[j][3] * v[j][3]); }
        s = wave_sum(s);
        u32x2* o8 = (u32x2*)(XB + (size_t)m * DM) + lane;
#pragma unroll
        for (int j = 0; j < 4; ++j) { u32x2 w; w.x = cvt_pk_bf16(v[j][0], v[j][1]); w.y = cvt_pk_bf16(v[j][2], v[j][3]); o8[64 * j] = w; }
        if (lane < 16) SSQ[(size_t)m * 16 + lane] = (lane == 0) ? s : 0.f;
    }
    { float* TAB = (float*)(ws + WS_TAB); const float* tbl = a.in[23];
      for (int i = gw * 64 + lane; i < 8 * 128; i += NGW * 64) { const int h = i >> 7, d = i & 127; TAB[i] = tbl[(int)T5_BUCKET[d] * 8 + h] * LOG2E; } }
    { float* C1 = (float*)(ws + WS_C1);
      for (int o = gw; o < 256; o += NGW) { const int kv = o >> 7, n = o & 127; const float* pos = a.in[11 + kv]; const float* w1 = a.in[13 + 2 * kv]; float s = 0.f;
          for (int k = lane; k < 2048; k += 64) s += pos[k] * w1[(size_t)k * 128 + n];
          s = wave_sum(s); if (lane == 0) C1[o] = s; } }
}

constexpr int KVP = 144, KVT = 64 * KVP;
constexpr float NEG = -1.0e30f;
__device__ __forceinline__ int crow(int r, int h) { return (r & 3) + 8 * (r >> 2) + 4 * h; }
#define MFMA32(a, b, c) __builtin_amdgcn_mfma_f32_32x32x16_bf16((a), (b), (c), 0, 0, 0)
typedef short v4i16_t __attribute__((ext_vector_type(4)));
__device__ __forceinline__ s16x4 vtr(LAS const unsigned char* p) { return __builtin_bit_cast(s16x4, __builtin_amdgcn_ds_read_tr16_b64_v4i16((LAS v4i16_t*)p)); }

__device__ __forceinline__ void qk_tile(f32x16& p0, f32x16& p1, LAS const unsigned char* Kt, const bf16x8 (&qf)[4], int lane) {
    LAS const unsigned char* kp = Kt + (lane & 31) * KVP + 16 * (lane >> 5);
    f32x16 z = {}; p0 = z; p1 = z;
#pragma unroll
    for (int s = 0; s < 4; ++s) { const bf16x8 a0 = *(LAS const bf16x8*)(kp + 32 * s), a1 = *(LAS const bf16x8*)(kp + 32 * KVP + 32 * s);
        p0 = MFMA32(a0, qf[s], p0); p1 = MFMA32(a1, qf[s], p1); }
}
__device__ __forceinline__ void pv_tile(f32x16& o0, f32x16& o1, LAS const unsigned char* Vt, const bf16x8 (&pf)[4], int lane) {
    LAS const unsigned char* vp = Vt + (4 * (lane >> 5) + ((lane & 15) >> 2)) * KVP + (16 * ((lane >> 4) & 1) + 4 * (lane & 3)) * 2;
#pragma unroll
    for (int s = 0; s < 4; ++s) {
        const s16x4 l0 = vtr(vp + (16 * s) * KVP), h0 = vtr(vp + (16 * s + 8) * KVP), l1 = vtr(vp + (16 * s) * KVP + 64), h1 = vtr(vp + (16 * s + 8) * KVP + 64);
        const bf16x8 v0 = {l0[0], l0[1], l0[2], l0[3], h0[0], h0[1], h0[2], h0[3]}, v1 = {l1[0], l1[1], l1[2], l1[3], h1[0], h1[1], h1[2], h1[3]};
        o0 = MFMA32(v0, pf[s], o0); o1 = MFMA32(v1, pf[s], o1); }
}
__device__ __forceinline__ void pack_p(bf16x8 (&pf)[4], const f32x16& p0, const f32x16& p1) {
#pragma unroll
    for (int s = 0; s < 4; ++s) { const f32x16& p = (s < 2) ? p0 : p1; const int b = 8 * (s & 1);
        u32x4 w; w.x = cvt_pk_bf16(p[b], p[b + 1]); w.y = cvt_pk_bf16(p[b + 2], p[b + 3]); w.z = cvt_pk_bf16(p[b + 4], p[b + 5]); w.w = cvt_pk_bf16(p[b + 6], p[b + 7]);
        pf[s] = __builtin_bit_cast(bf16x8, w); }
}
struct FState { f32x16 o0, o1; float m, l; };
__device__ __forceinline__ void fstate_init(FState& st) { f32x16 z = {}; st.o0 = z; st.o1 = z; st.m = NEG; st.l = 0.f; }
__device__ __forceinline__ void softmax_pv(FState& st, f32x16& p0, f32x16& p1, LAS const unsigned char* Vt, int lane) {
    float mx = fmaxf(p0[0], p1[0]);
#pragma unroll
    for (int r = 1; r < 16; ++r) mx = fmaxf(mx, fmaxf(p0[r], p1[r]));
    mx = fmaxf(mx, __shfl_xor(mx, 32));
    const float mn = fmaxf(st.m, mx), alpha = __builtin_amdgcn_exp2f(st.m - mn);
    float sum = 0.f;
#pragma unroll
    for (int r = 0; r < 16; ++r) { const float e0 = (p0[r] > -1.0e29f) ? __builtin_amdgcn_exp2f(p0[r] - mn) : 0.f, e1 = (p1[r] > -1.0e29f) ? __builtin_amdgcn_exp2f(p1[r] - mn) : 0.f;
        p0[r] = e0; p1[r] = e1; sum += e0 + e1; }
    st.l = st.l * alpha + sum; st.m = mn; st.o0 *= alpha; st.o1 *= alpha;
    bf16x8 pf[4]; pack_p(pf, p0, p1);
    pv_tile(st.o0, st.o1, Vt, pf, lane);
}
__device__ __forceinline__ u32x4 tile_ld(const bf16_t* base, int pitch, int tid) { return *(const u32x4*)(base + (size_t)(tid >> 3) * pitch + (tid & 7) * 8); }
__device__ __forceinline__ void tile_st(LAS unsigned char* T, u32x4 v, int tid) { *(LAS u32x4*)(T + (tid >> 3) * KVP + (tid & 7) * 16) = v; }

template <int MODE> __device__ __forceinline__ void flash_loop(FState& st, unsigned tiles, const bf16_t* Kg, const bf16_t* Vg, int pitch, LAS unsigned char* kvb, const bf16x8 (&qf)[4],
                                                               LAS const float* aux, int t, int R0, unsigned selbits, int tq, int tid, int lane) {
    if (tiles == 0u) return;
    const int h = lane >> 5;
    int cur = 0;
    { const int j0 = __builtin_ctz(tiles); const u32x4 k = tile_ld(Kg + (size_t)(64 * j0) * pitch, pitch, tid), v = tile_ld(Vg + (size_t)(64 * j0) * pitch, pitch, tid);
      tile_st(kvb, k, tid); tile_st(kvb + KVT, v, tid); }
    __syncthreads();
    float cq = 0.f; if (MODE == 0) cq = aux[t];
    while (tiles) {
        const int j = __builtin_ctz(tiles); tiles &= tiles - 1u;
        u32x4 kn = {}, vn = {};
        if (tiles) { const int jn = __builtin_ctz(tiles); kn = tile_ld(Kg + (size_t)(64 * jn) * pitch, pitch, tid); vn = tile_ld(Vg + (size_t)(64 * jn) * pitch, pitch, tid); }
        LAS unsigned char* Kt = kvb + cur * 2 * KVT; LAS unsigned char* Vt = Kt + KVT;
        bool act;
        if (MODE == 0) act = (64 * j <= R0 + 31);
        else if (MODE == 1) act = __any((selbits >> j) & 1u);
        else act = true;
        if (act) {
            f32x16 p0, p1; qk_tile(p0, p1, Kt, qf, lane);
            const int kb = 64 * j + 4 * h;
            if (MODE == 0) {
#pragma unroll
                for (int g4 = 0; g4 < 4; ++g4) { const f32x4 c0 = *(LAS const f32x4*)(aux + kb + 8 * g4), c1 = *(LAS const f32x4*)(aux + kb + 8 * g4 + 32);
#pragma unroll
                    for (int i = 0; i < 4; ++i) { p0[4 * g4 + i] += cq - c0[i]; p1[4 * g4 + i] += cq - c1[i]; } }
                if (64 * j + 63 > R0) {
#pragma unroll
                    for (int r = 0; r < 16; ++r) { const int kp = kb + (r & 3) + 8 * (r >> 2); if (kp > t) p0[r] = NEG; if (kp + 32 > t) p1[r] = NEG; } }
            } else {
                if (j + 3 <= tq) { const float c31 = aux[127];
#pragma unroll
                    for (int r = 0; r < 16; ++r) { p0[r] += c31; p1[r] += c31; }
                } else {
#pragma unroll
                    for (int r = 0; r < 16; ++r) { const int d0 = t - (kb + (r & 3) + 8 * (r >> 2)), d1 = d0 - 32;
                        p0[r] += aux[min(max(d0, 0), 127)]; p1[r] += aux[min(max(d1, 0), 127)]; }
                }
                if (MODE == 1) {
                    const bool sel = (selbits >> j) & 1u;
                    if (j == tq) {
#pragma unroll
                        for (int r = 0; r < 16; ++r) { const int kp = kb + (r & 3) + 8 * (r >> 2); if (!sel || kp > t) p0[r] = NEG; if (!sel || kp + 32 > t) p1[r] = NEG; }
                    } else {
#pragma unroll
                        for (int r = 0; r < 16; ++r) { if (!sel) { p0[r] = NEG; p1[r] = NEG; } }
                    }
                } else {
                    if (j == tq || j + 8 == tq) {
#pragma unroll
                        for (int r = 0; r < 16; ++r) { const int d0 = t - (kb + (r & 3) + 8 * (r >> 2)), d1 = d0 - 32; if (d0 < 0 || d0 >= 512) p0[r] = NEG; if (d1 < 0 || d1 >= 512) p1[r] = NEG; }
                    }
                }
            }
            softmax_pv(st, p0, p1, Vt, lane);
        }
        if (tiles) { LAS unsigned char* Kn = kvb + (cur ^ 1) * 2 * KVT; tile_st(Kn, kn, tid); tile_st(Kn + KVT, vn, tid); }
        __syncthreads();
        cur ^= 1;
    }
}
__device__ __forceinline__ void store_ot(bf16_t* orow, const f32x16& o0, const f32x16& o1, int h) {
#pragma unroll
    for (int g4 = 0; g4 < 4; ++g4) { u32x2 w0, w1; w0.x = cvt_pk_bf16(o0[4 * g4], o0[4 * g4 + 1]); w0.y = cvt_pk_bf16(o0[4 * g4 + 2], o0[4 * g4 + 3]); w1.x = cvt_pk_bf16(o1[4 * g4], o1[4 * g4 + 1]); w1.y = cvt_pk_bf16(o1[4 * g4 + 2], o1[4 * g4 + 3]);
        *(u32x2*)(orow + 8 * g4 + 4 * h) = w0; *(u32x2*)(orow + 32 + 8 * g4 + 4 * h) = w1; }
}

__device__ __forceinline__ void compress_unit(int U, const Args& a, LAS unsigned char* lds, int tid, int wave, int lane) {
    unsigned char* ws = a.ws;
    const int kv = U & 1, ct = (U >> 1) & 3, g = (U >> 3) & 1, b = U >> 4;
    const bf16_t* SRC = (const bf16_t*)(ws + WS_A + (kv ? A_VC : A_KC));
    const bf16_t* W1T = (const bf16_t*)(ws + (kv ? WS_CW1V : WS_CW1K));
    const bf16_t* W2T = (const bf16_t*)(ws + (kv ? WS_CW2V : WS_CW2K));
    const float* C1 = (const float*)(ws + WS_C1) + 128 * kv;
    bf16_t* DST = (bf16_t*)(ws + (kv ? WS_VCMP : WS_KCMP)) + (size_t)((b * 2 + g) * 128 + 32 * ct) * 64;
    LAS float* hid = (LAS float*)lds;
    LAS unsigned char* hb = lds + 16640;
    LAS float* out2 = (LAS float*)(lds + 16640 + 8704);
    const int nt = wave & 3, kh = wave >> 2, i = lane & 31, h = lane >> 5;
    const int c = min(32 * ct + i, 126);
    const bf16_t* arow = SRC + (size_t)(b * SEQ + 16 * c + 16 * kh) * 128 + 64 * g + 8 * h;
    const bf16_t* brow = W1T + (size_t)(32 * nt + i) * 2048 + (16 * kh) * 64 + 8 * h;
    f32x16 acc = {};
#pragma unroll 4
    for (int lt = 0; lt < 16; ++lt)
#pragma unroll
        for (int s = 0; s < 4; ++s) { const bf16x8 av = *(const bf16x8*)(arow + lt * 128 + 16 * s), bv = *(const bf16x8*)(brow + lt * 64 + 16 * s); acc = MFMA32(av, bv, acc); }
    if (kh == 1) {
#pragma unroll
        for (int r = 0; r < 16; ++r) hid[crow(r, h) * 129 + 32 * nt + i] = acc[r];
    }
    __syncthreads();
    if (kh == 0) { const float c1 = C1[32 * nt + i];
#pragma unroll
        for (int r = 0; r < 16; ++r) { const float v = acc[r] + hid[crow(r, h) * 129 + 32 * nt + i] + c1; const float sv = pg8::silu_f(v);
            *(LAS bf16_t*)(hb + crow(r, h) * 272 + (32 * nt + i) * 2) = (bf16_t)(cvt_pk_bf16(sv, 0.f) & 0xffffu); }
    }
    __syncthreads();
    if (wave < 2) { f32x16 a2 = {};
#pragma unroll
        for (int s = 0; s < 8; ++s) { const bf16x8 av = *(LAS const bf16x8*)(hb + i * 272 + (16 * s + 8 * h) * 2), bv = *(const bf16x8*)(W2T + (size_t)(32 * wave + i) * 128 + 16 * s + 8 * h); a2 = MFMA32(av, bv, a2); }
#pragma unroll
        for (int r = 0; r < 16; ++r) out2[crow(r, h) * 65 + 32 * wave + i] = a2[r];
    }
    __syncthreads();
    { const int cl = tid >> 4, e4 = (tid & 15) * 4; float v[4]; float ss = 0.f;
#pragma unroll
      for (int q = 0; q < 4; ++q) { v[q] = out2[cl * 65 + e4 + q]; ss += v[q] * v[q]; }
      if (kv == 0) { ss += __shfl_xor(ss, 1); ss += __shfl_xor(ss, 2); ss += __shfl_xor(ss, 4); ss += __shfl_xor(ss, 8);
          const float rs = __builtin_amdgcn_rsqf(ss * (1.0f / 64.0f) + RMS_EPS); const float* gn = a.in[8];
#pragma unroll
          for (int q = 0; q < 4; ++q) v[q] = v[q] * rs * gn[e4 + q]; }
      if (32 * ct + cl >= 127) { v[0] = 0.f; v[1] = 0.f; v[2] = 0.f; v[3] = 0.f; }
      u32x2 w; w.x = cvt_pk_bf16(v[0], v[1]); w.y = cvt_pk_bf16(v[2], v[3]); *(u32x2*)(DST + (size_t)cl * 64 + e4) = w; }
    __syncthreads();
}

__device__ __forceinline__ void fox_unit(int b, int hh, int qb, const Args& a, LAS unsigned char* lds, int tid, int wave, int lane) {
    unsigned char* ws = a.ws;
    const bf16_t* QB = (const bf16_t*)(ws + WS_A + A_QB); const bf16_t* KB = (const bf16_t*)(ws + WS_A + A_KB); const bf16_t* VB = (const bf16_t*)(ws + WS_A + A_VB);
    const float* LF = (const float*)(ws + WS_LF); bf16_t* OF = (bf16_t*)(ws + WS_XB + 32 * MiB);
    LAS float* cum2 = (LAS float*)(lds + 4 * KVT); LAS float* wsum = (LAS float*)(lds + 4 * KVT + 8192);
    const int nrows = 256 * (qb + 1), h = lane >> 5;
    { float v[4];
#pragma unroll
      for (int i = 0; i < 4; ++i) { const int s = 4 * tid + i; v[i] = (s < nrows) ? LF[(size_t)(b * SEQ + s) * 8 + hh] : 0.f; }
      v[1] += v[0]; v[2] += v[1]; v[3] += v[2];
      float tot = v[3];
#pragma unroll
      for (int off = 1; off < 64; off <<= 1) { const float tt = __shfl_up(tot, off); if (lane >= off) tot += tt; }
      if (lane == 63) wsum[wave] = tot;
      __syncthreads();
      float base = 0.f;
      for (int i = 0; i < wave; ++i) base += wsum[i];
      const float excl = (tot - v[3]) + base;
#pragma unroll
      for (int i = 0; i < 4; ++i) cum2[4 * tid + i] = (v[i] + excl) * LOG2E;
      __syncthreads(); }
    const int R0 = 256 * qb + 32 * wave, t = R0 + (lane & 31); const size_t row = (size_t)b * SEQ + t;
    bf16x8 qf[4];
#pragma unroll
    for (int s = 0; s < 4; ++s) qf[s] = *(const bf16x8*)(QB + row * 512 + hh * 64 + 16 * s + 8 * h);
    FState st; fstate_init(st);
    const unsigned tiles = (qb == 7) ? 0xffffffffu : ((1u << (4 * qb + 4)) - 1u);
    flash_loop<0>(st, tiles, KB + (size_t)b * SEQ * 512 + hh * 64, VB + (size_t)b * SEQ * 512 + hh * 64, 512, lds, qf, cum2, t, R0, 0u, 0, tid, lane);
    float l = st.l + __shfl_xor(st.l, 32); const float inv = (l > 0.f) ? 1.0f / l : 0.f;
    st.o0 *= inv; st.o1 *= inv;
    store_ot(OF + row * 512 + hh * 64, st.o0, st.o1, h);
    __syncthreads();
}

constexpr int NL_CMP = 4 * KVT, NL_IMP = 8 * KVT, NL_SEL = NL_IMP + 4 * 64 * 33 * 4, NL_UNI = NL_SEL + 256, NL_TAB = NL_SEL + 512;
__device__ __forceinline__ void nsa_unit(int b, int g, int tq, const Args& a, LAS unsigned char* lds, int tid, int wave, int lane) {
    unsigned char* ws = a.ws;
    const bf16_t* QA = (const bf16_t*)(ws + WS_A + A_QA);
    const bf16_t* KS = (const bf16_t*)(ws + WS_A + A_KS); const bf16_t* VS = (const bf16_t*)(ws + WS_A + A_VS);
    const bf16_t* KW = (const bf16_t*)(ws + WS_A + A_KW); const bf16_t* VW = (const bf16_t*)(ws + WS_A + A_VW);
    const bf16_t* KCM = (const bf16_t*)(ws + WS_KCMP) + (size_t)(b * 2 + g) * 128 * 64; const bf16_t* VCM = (const bf16_t*)(ws + WS_VCMP) + (size_t)(b * 2 + g) * 128 * 64;
    const float* GA = (const float*)(ws + WS_GA); bf16_t* ON = (bf16_t*)(ws + WS_XB);
    LAS unsigned char* cmpb = lds + NL_CMP;
    LAS float* imp = (LAS float*)(lds + NL_IMP);
    LAS unsigned* selm = (LAS unsigned*)(lds + NL_SEL); LAS unsigned* uni = (LAS unsigned*)(lds + NL_UNI);
    const int hr = wave >> 1, th = wave & 1, head = 4 * g + hr, h = lane >> 5, tl = 32 * th + (lane & 31), t = 64 * tq + tl;
    const size_t row = (size_t)b * SEQ + t;
    LAS const float* tabh = (LAS const float*)(lds + NL_TAB) + 128 * head;
    bf16x8 qf[4];
#pragma unroll
    for (int s = 0; s < 4; ++s) qf[s] = *(const bf16x8*)(QA + row * 512 + head * 64 + 16 * s + 8 * h);
    const int nct = (4 * tq + 3 > 64) ? 2 : 1;
    for (int i = 0; i < nct; ++i) { tile_st(cmpb + i * KVT, tile_ld(KCM + (size_t)i * 64 * 64, 64, tid), tid); tile_st(cmpb + (2 + i) * KVT, tile_ld(VCM + (size_t)i * 64 * 64, 64, tid), tid); }
    if (tid == 0) uni[0] = 0u;
    __syncthreads();
    f32x16 acc0, acc1;
    {
#define CMP_LOGITS(ti) do { qk_tile(p0, p1, cmpb + (ti) * KVT, qf, lane); \
            _Pragma("unroll") for (int r = 0; r < 16; ++r) { const int c = 64 * (ti) + crow(r, h); const int d0 = t - (16 * c + 31), d1 = d0 - 512; \
                p0[r] = (d0 >= 0) ? p0[r] + tabh[min(d0, 127)] : NEG; p1[r] = (d1 >= 0) ? p1[r] + tabh[min(d1, 127)] : NEG; } } while (0)
        f32x16 p0, p1; float mx = NEG, sum = 0.f;
#define CMP_PASS1(ti) do { CMP_LOGITS(ti); float tm = fmaxf(p0[0], p1[0]); _Pragma("unroll") for (int r = 1; r < 16; ++r) tm = fmaxf(tm, fmaxf(p0[r], p1[r])); \
            tm = fmaxf(tm, __shfl_xor(tm, 32)); const float mn = fmaxf(mx, tm); float sacc = 0.f; \
            _Pragma("unroll") for (int r = 0; r < 16; ++r) { sacc += ((p0[r] > -1.0e29f) ? __builtin_amdgcn_exp2f(p0[r] - mn) : 0.f) + ((p1[r] > -1.0e29f) ? __builtin_amdgcn_exp2f(p1[r] - mn) : 0.f); } \
            sum = sum * __builtin_amdgcn_exp2f(mx - mn) + sacc; mx = mn; } while (0)
        CMP_PASS1(0);
        if (nct > 1) CMP_PASS1(1);
        sum += __shfl_xor(sum, 32);
        const float inv = (sum > 0.f) ? 1.0f / sum : 0.f;
        f32x16 z = {}; acc0 = z; acc1 = z;
        LAS float* ip = imp + (hr * 64 + tl) * 33 + h; float carry = 0.f;
#define IMP_TILE(P, T) _Pragma("unroll") for (int qd = 0; qd < 4; ++qd) { const float own = (P[4 * qd] + P[4 * qd + 1]) + (P[4 * qd + 2] + P[4 * qd + 3]); const float rc = __shfl_xor(P[4 * qd + 3], 32); \
              ip[2 * (4 * (T) + qd)] = own + (h ? rc : carry); carry = rc; }
#define CMP_PASS2(ti) do { CMP_LOGITS(ti); \
            _Pragma("unroll") for (int r = 0; r < 16; ++r) { p0[r] = (p0[r] > -1.0e29f) ? __builtin_amdgcn_exp2f(p0[r] - mx) * inv : 0.f; p1[r] = (p1[r] > -1.0e29f) ? __builtin_amdgcn_exp2f(p1[r] - mx) * inv : 0.f; } \
            IMP_TILE(p0, 2 * (ti)) IMP_TILE(p1, 2 * (ti) + 1) \
            bf16x8 pf[4]; pack_p(pf, p0, p1); pv_tile(acc0, acc1, cmpb + (2 + (ti)) * KVT, pf, lane); } while (0)
        CMP_PASS2(0);
        if (nct > 1) CMP_PASS2(1);
#undef CMP_LOGITS
#undef CMP_PASS1
#undef CMP_PASS2
#undef IMP_TILE
        const float g_c = GA[row * 24 + head];
        acc0 *= g_c; acc1 *= g_c;
    }
    __syncthreads();
    if (tid < 64) {
        LAS float* r0 = imp + tid * 33;
        for (int j = 0; j <= tq; ++j) { float s = (r0[j] + imp[(64 + tid) * 33 + j]) + (imp[(128 + tid) * 33 + j] + imp[(192 + tid) * 33 + j]); r0[j] = s; }
        unsigned sel = 1u | (1u << tq); if (tq > 0) sel |= 1u << (tq - 1);
        const int need = 8 - __builtin_popcount(sel);
        for (int it = 0; it < need; ++it) { int best = -1; float bv = -3.0e38f;
            for (int j = 0; j <= tq; ++j) { if (!((sel >> j) & 1u)) { const float v = r0[j]; if (v > bv) { bv = v; best = j; } } }
            if (best >= 0) sel |= 1u << best; }
        selm[tid] = sel; atomicOr((unsigned*)uni, sel);
    }
    __syncthreads();
    const unsigned selbits = selm[tl], utiles = uni[0];
    { FState st; fstate_init(st);
      flash_loop<1>(st, utiles, KS + (size_t)b * SEQ * 128 + 64 * g, VS + (size_t)b * SEQ * 128 + 64 * g, 128, lds, qf, tabh, t, 0, selbits, tq, tid, lane);
      float l = st.l + __shfl_xor(st.l, 32); int l2 = lane; asm volatile("" : "+v"(l2)); const size_t row2 = (size_t)b * SEQ + 64 * tq + 32 * th + (l2 & 31);
      const float g_s = GA[row2 * 24 + 8 + head]; const float sc = (l > 0.f) ? g_s / l : 0.f;
      acc0 += st.o0 * sc; acc1 += st.o1 * sc; }
    { FState st; fstate_init(st);
      const int jlo = max(tq - 8, 0); const unsigned hi = (tq == 31) ? 0xffffffffu : ((1u << (tq + 1)) - 1u); const unsigned wt = hi & ~((1u << jlo) - 1u);
      flash_loop<2>(st, wt, KW + (size_t)b * SEQ * 128 + 64 * g, VW + (size_t)b * SEQ * 128 + 64 * g, 128, lds, qf, tabh, t, 0, 0u, tq, tid, lane);
      float l = st.l + __shfl_xor(st.l, 32); int l2 = lane; asm volatile("" : "+v"(l2)); const size_t row2 = (size_t)b * SEQ + 64 * tq + 32 * th + (l2 & 31);
      const float g_w = GA[row2 * 24 + 16 + head]; const float sc = (l > 0.f) ? g_w / l : 0.f;
      acc0 += st.o0 * sc; acc1 += st.o1 * sc;
      store_ot(ON + row2 * 512 + head * 64, acc0, acc1, l2 >> 5); }
    __syncthreads();
}
#define XB_TMO      128
#define XB_XCNT(j)  (256  + 64 * (j))
#define XB_XSUB(j)  (1280 + 64 * (j))
#define XB_XGEN(j)  (2304 + 64 * (j))
#define XB_TOP      3328
#define XB_TOPGEN   3392
#define XCD_BAR_WORDS 3456
#define XB_SPIN_CAP (1u << 18)

__device__ __forceinline__ unsigned xb_ld(unsigned* p)              { return __hip_atomic_load(p, __ATOMIC_RELAXED, __HIP_MEMORY_SCOPE_AGENT); }
__device__ __forceinline__ unsigned xb_add(unsigned* p, unsigned v) { return __hip_atomic_fetch_add(p, v, __ATOMIC_RELAXED, __HIP_MEMORY_SCOPE_AGENT); }
__device__ __forceinline__ unsigned xb_xcc_id() { return (unsigned)__builtin_amdgcn_s_getreg((3 << 11) | 20) & 0xFu; }
#define XB_SPIN(cond, bar) do { unsigned _sp = 0; while (cond) { __builtin_amdgcn_s_sleep(1); \
    if ((++_sp & 255u) == 0u) { if (xb_ld(&(bar)[XB_TMO])) break; if (_sp > XB_SPIN_CAP) { atomicAdd(&(bar)[XB_TMO], 1u); break; } } } } while (0)

struct XcdBarrier {
    unsigned* bar; unsigned x;
    volatile LAS unsigned* st;
};

__device__ __forceinline__ XcdBarrier xcd_barrier_post(unsigned* bar, volatile LAS unsigned* st, int tid) {
    XcdBarrier b; b.bar = bar; b.x = xb_xcc_id(); b.st = st;
    if (tid == 0) (void)xb_add(&bar[XB_XCNT(b.x)], 1u);
    return b;
}
__device__ __forceinline__ void xcd_barrier_complete(unsigned* bar, unsigned x, unsigned& nloc, unsigned& nx) {
    const unsigned G = gridDim.x;
    unsigned sum, cnt, mine, sp = 0u;
    for (;;) {
        sum = 0u; cnt = 0u; mine = 0u;
#pragma unroll
        for (unsigned j = 0; j < 16; ++j) { const unsigned c = xb_ld(&bar[XB_XCNT(j)]); sum += c; cnt += (c > 0u) ? 1u : 0u; mine = (j == x) ? c : mine; }
        if (sum == G) break;
        __builtin_amdgcn_s_sleep(1);
        if ((++sp & 255u) == 0u) { if (xb_ld(&bar[XB_TMO])) break; if (sp > XB_SPIN_CAP) { atomicAdd(&bar[XB_TMO], 1u); break; } }
    }
    nloc = mine > 0u ? mine : 1u; nx = cnt > 0u ? cnt : 1u;
}

__device__ __forceinline__ void xcd_barrier(const XcdBarrier& b, int tid) {
    asm volatile("s_waitcnt vmcnt(0)" ::: "memory");
    __syncthreads();
    if (tid == 0) {
        unsigned* bar = b.bar;
        __builtin_amdgcn_s_waitcnt(0);
        unsigned nloc = b.st[0], nx = b.st[1];
        if (nloc == 0u) { xcd_barrier_complete(bar, b.x, nloc, nx); b.st[0] = nloc; b.st[1] = nx; }
        const unsigned old = xb_add(&bar[XB_XSUB(b.x)], 1u);
        const unsigned gen = old / nloc;
        if (old + 1u == (gen + 1u) * nloc) {
            __builtin_amdgcn_fence(__ATOMIC_RELEASE, "agent");
            asm volatile("s_waitcnt vmcnt(0)" ::: "memory");
            const unsigned og = xb_add(&bar[XB_TOP], 1u);
            const unsigned tg = og / nx;
            if (og + 1u == (tg + 1u) * nx) xb_add(&bar[XB_TOPGEN], 1u);
            else XB_SPIN(xb_ld(&bar[XB_TOPGEN]) == tg, bar);
            __builtin_amdgcn_fence(__ATOMIC_ACQUIRE, "agent");
            xb_add(&bar[XB_XGEN(b.x)], 1u);
            asm volatile("s_waitcnt vmcnt(0)" ::: "memory");
        } else {
            XB_SPIN(xb_ld(&bar[XB_XGEN(b.x)]) == gen, bar);
            __builtin_amdgcn_fence(__ATOMIC_ACQUIRE, "agent");
            asm volatile("s_waitcnt vmcnt(0)" ::: "memory");
        }
    }
    __syncthreads();
}

constexpr int NPHASE = 11;
#ifndef PHMASK
#define PHMASK 0xfff
#endif
#ifndef MK_MULTI_LAUNCH
#define MK_MULTI_LAUNCH 0
#endif
__global__ void __launch_bounds__(NTHREADS, 2) fwd_kernel(Args a) {
    extern __shared__ __attribute__((aligned(16))) unsigned char lds_raw[];
    LAS unsigned char* lds = (LAS unsigned char*)lds_raw;
    const int G = gridDim.x, bx = blockIdx.x, vcu = (G % 8 == 0) ? (bx % 8) * (G / 8) + bx / 8 : bx;
    unsigned char* ws = a.ws;
    bf16_t* XB = (bf16_t*)(ws + WS_XB); bf16_t* HB = (bf16_t*)(ws + WS_A); bf16_t* MERGED = (bf16_t*)(ws + WS_A); float* SSQ = (float*)(ws + WS_SSQ);
    bf16_t* GM = (bf16_t*)(ws + WS_A + A_GM);
    const int lo = a.ph_lo, hi = a.ph_hi;
    const int wave_s = __builtin_amdgcn_readfirstlane(threadIdx.x >> 6);
#define MYTID() (wave_s * 64 + (int)__builtin_amdgcn_mbcnt_hi(~0u, __builtin_amdgcn_mbcnt_lo(~0u, 0u)))
#define IN(k) (lo <= (k) && (k) < hi)
#define SYNC_AFTER(k) do { if (IN(k) && IN((k) + 1)) xcd_barrier(bar, MYTID()); } while (0)
#define OPAQUE_TID() int tid = MYTID(); asm volatile("" : "+v"(tid)); const int lane = tid & 63, wave = __builtin_amdgcn_readfirstlane(tid >> 6); (void)lane; (void)wave
#define GEMM_SWIGLU(k, WOFF) if (IN(k)) { pg8::Gemm g{XB, (const bf16_t*)(ws + (WOFF)), MTOK, NUP, DM}; pg8::StaticOrder S; S.init(MTOK, NUP, G, bx); pg8::EpiSwiGLU E{HB, DFF, SSQ}; \
        pg8::gemm_phase<pg8::EpiSwiGLU, pg8::StaticOrder, true, true>(lds, g, S, E, MYTID()); }
#define GEMM_RESID(k, APTR, WOFF, KDIM, BASE, ALPHA, XBP, SSQP) if (IN(k)) { pg8::Gemm g{(APTR), (const bf16_t*)(ws + (WOFF)), MTOK, DM, (KDIM)}; pg8::StaticOrder S; S.init(MTOK, DM, G, bx); \
        pg8::EpiResid E{(BASE), a.out, (ALPHA), (XBP), (SSQP)}; pg8::gemm_phase<pg8::EpiResid, pg8::StaticOrder, true, true>(lds, g, S, E, MYTID()); }
#define GEMM_GATE(k, APTR, WOFF, GOFF, FIRST) if (IN(k)) { pg8::Gemm g{(APTR), (const bf16_t*)(ws + (WOFF)), MTOK, DM, 512}; pg8::StaticOrder S; S.init(MTOK, DM, G, bx); \
        pg8::EpiGate E{MERGED, GM, (GOFF), (FIRST)}; pg8::gemm_phase<pg8::EpiGate, pg8::StaticOrder, true, true>(lds, g, S, E, MYTID()); }
    { volatile LAS unsigned* stw = (volatile LAS unsigned*)(lds + 131072); if (threadIdx.x == 0) { stw[0] = 0u; stw[1] = 0u; } __syncthreads(); }
    const XcdBarrier bar = xcd_barrier_post((unsigned*)ws, (volatile LAS unsigned*)(lds + 131072), (int)threadIdx.x);
    if (IN(0)) { OPAQUE_TID(); prep_phase(a, lds, vcu, G, wave, lane); }
    if (IN(0) && IN(1)) cg::this_grid().sync();
    GEMM_SWIGLU(1, WS_WUP1)
    SYNC_AFTER(1);
    GEMM_RESID(2, HB, WS_WDN1, DFF, a.in[0], 0.5f, XB, SSQ)
    SYNC_AFTER(2);
    if (IN(3)) {
        pg8::Gemm g{XB, (const bf16_t*)(ws + WS_WIN), MTOK, NIN, DM}; pg8::StaticOrder S; S.init(MTOK, NIN, G, bx);
        pg8::EpiProj E; unsigned char* A = ws + WS_A;
        E.P.QA = (bf16_t*)(A + A_QA); E.P.KC = (bf16_t*)(A + A_KC); E.P.VC = (bf16_t*)(A + A_VC); E.P.KS = (bf16_t*)(A + A_KS); E.P.VS = (bf16_t*)(A + A_VS); E.P.KW = (bf16_t*)(A + A_KW); E.P.VW = (bf16_t*)(A + A_VW);
        E.P.QB = (bf16_t*)(A + A_QB); E.P.KB = (bf16_t*)(A + A_KB); E.P.VB = (bf16_t*)(A + A_VB); E.P.GM = GM; E.P.GA = (float*)(ws + WS_GA); E.P.LF = (float*)(ws + WS_LF);
        E.ssq = SSQ; E.nsa_q_gain = a.in[7]; E.nsa_k_gain = a.in[8]; E.fox_q_gain = a.in[9]; E.fox_k_gain = a.in[10]; E.b_forget = a.in[6];
        pg8::gemm_phase<pg8::EpiProj, pg8::StaticOrder, true, true>(lds, g, S, E, MYTID());
    }
    SYNC_AFTER(3);
    if (IN(4)) { OPAQUE_TID();
        for (int U = vcu; U < 256; U += G) compress_unit(U, a, lds, tid, wave, lane);
        for (int U = vcu; U < 1024; U += G) { const int i = U >> 8, v = U & 255, bh = v >> 1, half = v & 1; const int qb = (i == 0) ? half : (i == 1) ? 7 - half : (i == 2) ? 2 + half : 5 - half;
            fox_unit(bh >> 3, bh & 7, qb, a, lds, tid, wave, lane); }
    }
    SYNC_AFTER(4);
    if (IN(5)) { OPAQUE_TID();
        { const float* TAB = (const float*)(ws + WS_TAB); LAS float* tl = (LAS float*)(lds + NL_TAB); for (int i = tid; i < 1024; i += NTHREADS) tl[i] = TAB[i]; }
        __syncthreads();
        for (int U = vcu; U < 1024; U += G) { const int i = U >> 8, v = U & 255, bg = v >> 3, s = v & 7; const int tq = (i == 0) ? s : (i == 1) ? 15 - s : (i == 2) ? 16 + s : 31 - s;
            nsa_unit(bg >> 1, bg & 1, tq, a, lds, tid, wave, lane); }
    }
    SYNC_AFTER(5);
    GEMM_GATE(6, XB, WS_WON, 0, true)
    GEMM_GATE(7, XB + (size_t)MTOK * 512, WS_WOF, 1024, false)
    SYNC_AFTER(7);
    GEMM_RESID(8, MERGED, WS_WOUT, DM, a.out, 1.0f, XB, SSQ)
    SYNC_AFTER(8);
    GEMM_SWIGLU(9, WS_WUP2)
    SYNC_AFTER(9);
    GEMM_RESID(10, HB, WS_WDN2, DFF, a.out, 0.5f, (bf16_t*)nullptr, (float*)nullptr)
}

extern "C" void kernel_launch(void* const* d_in, const int* in_sizes, int n_in, void* d_out, int out_size, void* d_ws, size_t ws_size, hipStream_t stream) {
    static int grid = 0;
    if (grid == 0) {
        if (n_in != 24 || in_sizes[0] != MTOK * DM || out_size != MTOK * DM || ws_size < WS_END) { fprintf(stderr, "kernel_launch: unexpected shapes (n_in %d, in0 %d, out %d, ws %zu < %zu)\n", n_in, n_in > 0 ? in_sizes[0] : -1, out_size, ws_size, (size_t)WS_END); grid = -1; return; }
        int dev = 0, cus = 0, per_cu = 0;
        if (hipGetDevice(&dev) != hipSuccess || hipDeviceGetAttribute(&cus, hipDeviceAttributeMultiprocessorCount, dev) != hipSuccess) { grid = -1; return; }
        if (hipFuncSetAttribute((const void*)fwd_kernel, hipFuncAttributeMaxDynamicSharedMemorySize, LDS_BYTES) != hipSuccess) { fprintf(stderr, "kernel_launch: hipFuncSetAttribute failed\n"); grid = -1; return; }
        if (hipOccupancyMaxActiveBlocksPerMultiprocessor(&per_cu, (const void*)fwd_kernel, NTHREADS, LDS_BYTES) != hipSuccess || per_cu < 1) { fprintf(stderr, "kernel_launch: occupancy query reports %d blocks per CU\n", per_cu); (void)hipGetLastError(); grid = -1; return; }
        grid = cus;
    }
    if (grid < 0) return;
    if (hipMemsetAsync(d_ws, 0, 65536, stream) != hipSuccess) { fprintf(stderr, "kernel_launch: memset of the control words failed\n"); return; }
    Args a{};
    for (int i = 0; i < 24; ++i) a.in[i] = (const float*)d_in[i];
    a.out = (float*)d_out; a.ws = (unsigned char*)d_ws;
#if MK_MULTI_LAUNCH
    for (int ph = 0; ph < NPHASE; ++ph) { a.ph_lo = ph; a.ph_hi = ph + 1; hipLaunchKernelGGL(fwd_kernel, dim3(grid), dim3(NTHREADS), LDS_BYTES, stream, a); }
#else
    a.ph_lo = 0; a.ph_hi = NPHASE;
    void* args[] = {&a};
    const hipError_t e = hipLaunchCooperativeKernel((const void*)fwd_kernel, dim3(grid), dim3(NTHREADS), args, LDS_BYTES, stream);
    if (e != hipSuccess) fprintf(stderr, "kernel_launch: cooperative launch failed: %s (grid %d)\n", hipGetErrorString(e), grid);
#endif
}
```

```cpp
#include <hip/hip_runtime.h>
#include <hip/hip_cooperative_groups.h>
#include <cstdio>
#include <cstdint>
namespace cg = cooperative_groups;

namespace pg8 {
#define PG8_LAS __attribute__((address_space(3)))
typedef unsigned short bf16_t;
typedef short bf16x8 __attribute__((ext_vector_type(8)));
typedef float f32x4 __attribute__((ext_vector_type(4)));
typedef unsigned u32x4 __attribute__((ext_vector_type(4)));
constexpr int BM = 256, BK = 64, HALF = 128, HTB = HALF * BK * 2  , STAGE_BYTES = 8 * HTB, NXCD = 8, WGM = 8;

__host__ __device__ __forceinline__ int lds_byte(int r, int c) { const int st = (r >> 4) * 2 + (c >> 5), rr = r & 15, cc = c & 31, ob = rr * 64 + cc * 2; return st * 1024 + (ob ^ (((ob >> 9) & 1) << 5)); }
__host__ __device__ __forceinline__ void stage_rc(int b, int& R, int& C) { const int st = b / 1024, sb = b % 1024, swz = sb ^ (((sb >> 9) & 1) << 5); R = (st >> 1) * 16 + swz / 64; C = (st & 1) * 32 + (swz % 64) / 2; }
__host__ __device__ __forceinline__ int perm32(int rho) { const int n = rho >> 4, i = rho & 15; return 8 * (i >> 2) + 4 * n + (i & 3); }

struct Unit { int pm, pn; };
struct Gemm { const bf16_t* A; const bf16_t* Bt; int M, N, K; };

struct StaticOrder {
    int nM, nN, nwg, G, c;
    __host__ __device__ void init(int M, int N, int G_, int c_) { nM = M / BM; nN = N / BM; nwg = nM * nN; G = G_; c = c_; }
    __host__ __device__ bool next(int i, Unit& u) const {
        const long L = (long)i * G + c; if (L >= nwg) return false;
        int wgid = (int)L; { const int q = nwg / NXCD, r = nwg % NXCD, xcd = wgid % NXCD, off = wgid / NXCD; wgid = (xcd < r ? xcd * (q + 1) : r * (q + 1) + (xcd - r) * q) + off; }
        const int nig = WGM * nN, gid = wgid / nig, fm = gid * WGM, gsz = (nM - fm) < WGM ? (nM - fm) : WGM;
        u.pm = fm + ((wgid % nig) % gsz); u.pn = (wgid % nig) / gsz; return true;
    }
    __device__ __forceinline__ void a_ready(const Unit&) const {}
    __device__ __forceinline__ void done(const Unit&) const {}
};

typedef float f32x2 __attribute__((ext_vector_type(2)));
typedef __bf16 bf16x2_t __attribute__((ext_vector_type(2)));
typedef unsigned u32x2 __attribute__((ext_vector_type(2)));
__device__ __forceinline__ unsigned cvt_pk_bf16(float lo, float hi) { f32x2 v = {lo, hi}; bf16x2_t b = __builtin_convertvector(v, bf16x2_t); return __builtin_bit_cast(unsigned, b); }
__device__ __forceinline__ float bf_lo(unsigned w) { return __uint_as_float(w << 16); }
__device__ __forceinline__ float bf_hi(unsigned w) { return __uint_as_float(w & 0xffff0000u); }
constexpr float LOG2E = 1.4426950408889634f;
__device__ __forceinline__ float fast_sigmoid(float x) { return __builtin_amdgcn_rcpf(1.0f + __builtin_amdgcn_exp2f(-x * LOG2E)); }
__device__ __forceinline__ float silu_f(float x) { return x * fast_sigmoid(x); }
constexpr float RMS_EPS = 1e-6f;
__device__ __forceinline__ float row_rinv(const float* ssq, int row, int fq) {
    const f32x4 p = *(const f32x4*)(ssq + (size_t)row * 16 + 4 * fq);
    float s = (p[0] + p[1]) + (p[2] + p[3]);
    s += __shfl_xor(s, 16); s += __shfl_xor(s, 32);
    return __builtin_amdgcn_rsqf(s * (1.0f / 1024.0f) + RMS_EPS);
}

__device__ __forceinline__ void row_rinv8(float (&rs)[8], const float* ssq, int row0, int fq) {
    f32x4 pr[8];
#pragma unroll
    for (int q = 0; q < 8; ++q) pr[q] = *(const f32x4*)(ssq + (size_t)(row0 + (q >> 2) * HALF + (q & 3) * 16) * 16 + 4 * fq);
#pragma unroll
    for (int q = 0; q < 8; ++q) { float s = (pr[q][0] + pr[q][1]) + (pr[q][2] + pr[q][3]); s += __shfl_xor(s, 16); s += __shfl_xor(s, 32); rs[q] = __builtin_amdgcn_rsqf(s * (1.0f / 1024.0f) + RMS_EPS); }
}
struct EpiSwiGLU {
    static constexpr bool PERM = true, AFTER_DRAIN = false;
    bf16_t* H; int ldh; const float* ssq;
    __device__ __forceinline__ void operator()(const f32x4 (&acc)[2][2][4][2], const Unit& u, int wr, int wc, int fr, int fq) const {
        const int row0 = u.pm * BM + wr * 64 + fr, col0 = u.pn * HALF + wc * 32 + 8 * fq;
        float rsv[8]; row_rinv8(rsv, ssq, row0, fq);
#pragma unroll
        for (int ai = 0; ai < 2; ++ai)
#pragma unroll
            for (int m = 0; m < 4; ++m) { const int row = row0 + ai * HALF + m * 16; const float rs = rsv[ai * 4 + m];
                float o[8];
#pragma unroll
                for (int n = 0; n < 2; ++n)
#pragma unroll
                    for (int i = 0; i < 4; ++i) { const float g = acc[ai][0][m][n][i] * rs, up = acc[ai][1][m][n][i] * rs; o[4 * n + i] = silu_f(g) * up; }
                u32x4 w; w.x = cvt_pk_bf16(o[0], o[1]); w.y = cvt_pk_bf16(o[2], o[3]); w.z = cvt_pk_bf16(o[4], o[5]); w.w = cvt_pk_bf16(o[6], o[7]);
                *(u32x4*)(H + (size_t)row * ldh + col0) = w; }
    }
};

struct EpiResid {
    static constexpr bool PERM = false, AFTER_DRAIN = false;
    const float* base; float* out; float alpha; bf16_t* xb; float* ssq;
    __device__ __forceinline__ void operator()(const f32x4 (&acc)[2][2][4][2], const Unit& u, int wr, int wc, int fr, int fq) const {
        const int row0 = u.pm * BM + wr * 64 + fr, col0 = u.pn * BM + wc * 32 + 4 * fq;
#pragma unroll
        for (int ai = 0; ai < 2; ++ai) {
            f32x4 bs[4][2][2];
#pragma unroll
            for (int m = 0; m < 4; ++m) { const size_t off = (size_t)(row0 + ai * HALF + m * 16) * 1024 + col0;
#pragma unroll
                for (int bj = 0; bj < 2; ++bj)
#pragma unroll
                    for (int n = 0; n < 2; ++n) bs[m][bj][n] = *(const f32x4*)(base + off + bj * HALF + n * 16); }
            asm volatile("" ::: "memory");
#pragma unroll
            for (int m = 0; m < 4; ++m) { const int row = row0 + ai * HALF + m * 16; const size_t off = (size_t)row * 1024 + col0; float ss = 0.f;
#pragma unroll
                for (int bj = 0; bj < 2; ++bj)
#pragma unroll
                    for (int n = 0; n < 2; ++n) { const f32x4 v = bs[m][bj][n] + acc[ai][bj][m][n] * alpha;
                        *(f32x4*)(out + off + bj * HALF + n * 16) = v; ss += (v[0] * v[0] + v[1] * v[1]) + (v[2] * v[2] + v[3] * v[3]);
                        if (xb) { u32x2 w; w.x = cvt_pk_bf16(v[0], v[1]); w.y = cvt_pk_bf16(v[2], v[3]); *(u32x2*)(xb + off + bj * HALF + n * 16) = w; } }
                if (ssq) { ss += __shfl_xor(ss, 16); ss += __shfl_xor(ss, 32); if (fq == 0) ssq[(size_t)row * 16 + 4 * u.pn + wc] = ss; } }
            asm volatile("" ::: "memory");
        }
    }
};

struct EpiGate {
    static constexpr bool PERM = true, AFTER_DRAIN = false;
    bf16_t* T; const bf16_t* gate; int goff; bool first;
    __device__ __forceinline__ void operator()(const f32x4 (&acc)[2][2][4][2], const Unit& u, int wr, int wc, int fr, int fq) const {
        const int row0 = u.pm * BM + wr * 64 + fr, col0 = u.pn * BM + wc * 32 + 8 * fq;
#pragma unroll
        for (int ai = 0; ai < 2; ++ai) {
            u32x4 gw[4][2], tw[4][2];
#pragma unroll
            for (int m = 0; m < 4; ++m)
#pragma unroll
                for (int bj = 0; bj < 2; ++bj) { const int row = row0 + ai * HALF + m * 16, c = col0 + bj * HALF;
                    gw[m][bj] = *(const u32x4*)(gate + (size_t)row * 2048 + goff + c);
                    tw[m][bj] = first ? (u32x4){0u, 0u, 0u, 0u} : *(const u32x4*)(T + (size_t)row * 1024 + c); }
            asm volatile("" ::: "memory");
#pragma unroll
            for (int m = 0; m < 4; ++m)
#pragma unroll
                for (int bj = 0; bj < 2; ++bj) { const int row = row0 + ai * HALF + m * 16, c = col0 + bj * HALF;
                    float o[8];
#pragma unroll
                    for (int q = 0; q < 4; ++q) { o[2 * q] = bf_lo(gw[m][bj][q]) * acc[ai][bj][m][q >> 1][(2 * q) & 3] + bf_lo(tw[m][bj][q]); o[2 * q + 1] = bf_hi(gw[m][bj][q]) * acc[ai][bj][m][q >> 1][(2 * q + 1) & 3] + bf_hi(tw[m][bj][q]); }
                    u32x4 w; w.x = cvt_pk_bf16(o[0], o[1]); w.y = cvt_pk_bf16(o[2], o[3]); w.z = cvt_pk_bf16(o[4], o[5]); w.w = cvt_pk_bf16(o[6], o[7]);
                    *(u32x4*)(T + (size_t)row * 1024 + c) = w; }
            asm volatile("" ::: "memory");
        }
    }
};

struct ProjOut { bf16_t *QA, *KC, *VC, *KS, *VS, *KW, *VW, *QB, *KB, *VB, *GM; float *GA, *LF; };
constexpr float QSCALE = 0.125f * LOG2E;
struct EpiProj {
    static constexpr bool PERM = true, AFTER_DRAIN = false;
    ProjOut P; const float* ssq; const float *nsa_q_gain, *nsa_k_gain, *fox_q_gain, *fox_k_gain, *b_forget;
    __device__ __forceinline__ void operator()(const f32x4 (&acc)[2][2][4][2], const Unit& u, int wr, int wc, int fr, int fq) const {
        const int row0 = u.pm * BM + wr * 64 + fr; const int pn = u.pn;
        if (pn == 19) {
            if (wc != 0) return;
            f32x4 bfv[2]; bfv[0] = *(const f32x4*)(b_forget); bfv[1] = *(const f32x4*)(b_forget + 4);
            float rsv[8]; row_rinv8(rsv, ssq, row0, fq);
#pragma unroll
            for (int ai = 0; ai < 2; ++ai)
#pragma unroll
                for (int m = 0; m < 4; ++m) { const int row = row0 + ai * HALF + m * 16; const float rs = rsv[ai * 4 + m];
#pragma unroll
                    for (int n = 0; n < 2; ++n) { const f32x4 v = acc[ai][0][m][n] * rs; f32x4 o;
                        if (fq < 3) {
#pragma unroll
                            for (int i = 0; i < 4; ++i) o[i] = 1.0f / (1.0f + __expf(-v[i]));
                            *(f32x4*)(P.GA + (size_t)row * 24 + 8 * fq + 4 * n) = o;
                        } else {
#pragma unroll
                            for (int i = 0; i < 4; ++i) { const float x = v[i] + bfv[n][i]; o[i] = fminf(x, 0.f) - log1pf(__expf(-fabsf(x))); }
                            *(f32x4*)(P.LF + (size_t)row * 8 + 4 * n) = o;
                        } } }
            return;
        }
        int kind = 0; const float* gain = nullptr; float mul = 1.f; bf16_t* dst = nullptr; int pitch = 128;
        if (pn < 2) { kind = 1; gain = nsa_q_gain; mul = QSCALE; dst = P.QA + 256 * pn + 64 * wc; pitch = 512; }
        else if (pn == 2) { dst = (wc < 2) ? P.KC + 64 * wc : P.VC + 64 * (wc - 2); }
        else if (pn == 3) { if (wc < 2) { kind = 1; gain = nsa_k_gain + 64; dst = P.KS + 64 * wc; } else dst = P.VS + 64 * (wc - 2); }
        else if (pn == 4) { if (wc < 2) { kind = 1; gain = nsa_k_gain + 128; dst = P.KW + 64 * wc; } else dst = P.VW + 64 * (wc - 2); }
        else if (pn < 7) { kind = 1; gain = fox_q_gain; mul = QSCALE; dst = P.QB + 256 * (pn - 5) + 64 * wc; pitch = 512; }
        else if (pn < 9) { kind = 1; gain = fox_k_gain; dst = P.KB + 256 * (pn - 7) + 64 * wc; pitch = 512; }
        else if (pn < 11) { dst = P.VB + 256 * (pn - 9) + 64 * wc; pitch = 512; }
        else { kind = 2; dst = P.GM + 256 * (pn - 11) + 64 * wc; pitch = 2048; }
        f32x4 gv[2][2];
#pragma unroll
        for (int bj = 0; bj < 2; ++bj)
#pragma unroll
            for (int n = 0; n < 2; ++n) { gv[bj][n] = (f32x4){1.f, 1.f, 1.f, 1.f}; if (kind == 1) gv[bj][n] = *(const f32x4*)(gain + 32 * bj + 8 * fq + 4 * n); }
        float rsv[8]; row_rinv8(rsv, ssq, row0, fq);
#pragma unroll
        for (int ai = 0; ai < 2; ++ai)
#pragma unroll
            for (int m = 0; m < 4; ++m) { const int row = row0 + ai * HALF + m * 16; const float rs = rsv[ai * 4 + m];
                float hs = rs;
                if (kind == 1) { float ss = 0.f;
#pragma unroll
                    for (int bj = 0; bj < 2; ++bj)
#pragma unroll
                        for (int n = 0; n < 2; ++n) { const f32x4 v = acc[ai][bj][m][n] * rs; ss += (v[0] * v[0] + v[1] * v[1]) + (v[2] * v[2] + v[3] * v[3]); }
                    ss += __shfl_xor(ss, 16); ss += __shfl_xor(ss, 32); hs = rs * __builtin_amdgcn_rsqf(ss * (1.0f / 64.0f) + RMS_EPS) * mul; }
#pragma unroll
                for (int bj = 0; bj < 2; ++bj) { float o[8];
#pragma unroll
                    for (int n = 0; n < 2; ++n) { const f32x4 gvn = gv[bj][n];
#pragma unroll
                        for (int i = 0; i < 4; ++i) { float x = acc[ai][bj][m][n][i] * hs; if (kind == 2) x = fast_sigmoid(x); else x = x * gvn[i]; o[4 * n + i] = x; } }
                    u32x4 w; w.x = cvt_pk_bf16(o[0], o[1]); w.y = cvt_pk_bf16(o[2], o[3]); w.z = cvt_pk_bf16(o[4], o[5]); w.w = cvt_pk_bf16(o[6], o[7]);
                    *(u32x4*)(dst + (size_t)row * pitch + 32 * bj + 8 * fq) = w; } }
    }
};

template <class Epi, class Sched, bool ALIGN_EPI = false, bool SP2 = false>
__device__ __forceinline__ void gemm_phase(PG8_LAS unsigned char* lds, const Gemm g, const Sched& S, const Epi& E, int tid_in) {
    int tid_ = tid_in; asm volatile("" : "+v"(tid_));
    const int tid = tid_, wid = __builtin_amdgcn_readfirstlane(tid >> 6), lane = tid & 63, wr = wid >> 2, wc = wid & 3, fr = lane & 15, fq = lane >> 4;
    const int K = g.K, nt = K / BK;
    unsigned voffA[2], voffB[2];
#pragma unroll
    for (int i = 0; i < 2; ++i) { int R, C; stage_rc(tid * 16 + i * 8192, R, C); const int Rb = Epi::PERM ? ((R & ~31) + perm32(R & 31)) : R;
        voffA[i] = (unsigned)(R * K + C) * 2u; voffB[i] = (unsigned)(Rb * K + C) * 2u; }
    const size_t kstep = (size_t)(BK * 2);
    const size_t hstep = (size_t)HALF * K * 2;
    const size_t tstep = 2 * hstep;
    const unsigned ldsw = (unsigned)wid * 1024u;
    const int aoff = lds_byte(wr * 64 + fr, fq * 8), boff = lds_byte(wc * 32 + fr, fq * 8);
#define PG8_SA(b, h) (((b) * 2 + (h)) * HTB)
#define PG8_SB(b, h) ((4 + (b) * 2 + (h)) * HTB)
#define PG8_STAGE(bufoff, gbase, voff) do { _Pragma("unroll") for (int _i = 0; _i < 2; ++_i) \
        __builtin_amdgcn_global_load_lds((const unsigned*)((const char*)(gbase) + (voff)[_i]), (PG8_LAS unsigned*)(lds + (bufoff) + ldsw + _i * 8192), 16, 0, 0); } while (0)
#define PG8_LDA(dst, b, h) do { _Pragma("unroll") for (int m = 0; m < 4; ++m) _Pragma("unroll") for (int k = 0; k < 2; ++k) dst[m][k] = *(const PG8_LAS bf16x8*)(lds + PG8_SA(b, h) + aoff + m * 2048 + k * 1024); } while (0)
#define PG8_LDB(dst, b, h) do { _Pragma("unroll") for (int n = 0; n < 2; ++n) _Pragma("unroll") for (int k = 0; k < 2; ++k) dst[n][k] = *(const PG8_LAS bf16x8*)(lds + PG8_SB(b, h) + boff + n * 2048 + k * 1024); } while (0)
#define PG8_MMA(ai, bj, At, Bt) do { __builtin_amdgcn_s_setprio(1); _Pragma("unroll") for (int m = 0; m < 4; ++m) _Pragma("unroll") for (int n = 0; n < 2; ++n) _Pragma("unroll") for (int k = 0; k < 2; ++k) \
        acc[ai][bj][m][n] = __builtin_amdgcn_mfma_f32_16x16x32_bf16(Bt[n][k], At[m][k], acc[ai][bj][m][n], 0, 0, 0); __builtin_amdgcn_s_setprio(0); } while (0)
#define PG8_WAIT_V(n) asm volatile("s_waitcnt vmcnt(" #n ")" ::: "memory")
#define PG8_WAIT_L(n) asm volatile("s_waitcnt lgkmcnt(" #n ")" ::: "memory")
#define PG8_BAR __builtin_amdgcn_s_barrier()
#define PG8_SCHED __builtin_amdgcn_sched_barrier(0)
    Unit cur, nxt; int ui = 0;
    if (!S.next(0, cur)) return;
    f32x4 acc[2][2][4][2];
#pragma unroll
    for (int a = 0; a < 2; ++a)
#pragma unroll
        for (int b = 0; b < 2; ++b)
#pragma unroll
            for (int m = 0; m < 4; ++m)
#pragma unroll
                for (int n = 0; n < 2; ++n) acc[a][b][m][n] = (f32x4){0.f, 0.f, 0.f, 0.f};
    bf16x8 At[4][2], B0[2][2], B1[2][2];
    const char* cA = (const char*)g.A + (size_t)cur.pm * tstep; const char* cB = (const char*)g.Bt + (size_t)cur.pn * tstep;
    S.a_ready(cur);
    if constexpr (SP2) {
        PG8_STAGE(PG8_SB(0, 0), cB, voffB); PG8_STAGE(PG8_SB(0, 1), cB + hstep, voffB); PG8_STAGE(PG8_SA(0, 0), cA, voffA); PG8_STAGE(PG8_SA(0, 1), cA + hstep, voffA);
        if (wr == 1) PG8_BAR;
        PG8_WAIT_V(2); PG8_BAR;
        PG8_STAGE(PG8_SB(1, 0), cB + kstep, voffB); PG8_STAGE(PG8_SA(1, 0), cA + kstep, voffA); PG8_STAGE(PG8_SB(1, 1), cB + hstep + kstep, voffB);
        PG8_WAIT_V(6); PG8_BAR;
    } else {
        PG8_STAGE(PG8_SB(0, 0), cB, voffB); PG8_STAGE(PG8_SA(0, 0), cA, voffA); PG8_STAGE(PG8_SB(0, 1), cB + hstep, voffB); PG8_STAGE(PG8_SA(0, 1), cA + hstep, voffA);
        if (wr == 1) PG8_BAR;
        PG8_WAIT_V(4); PG8_BAR;
        PG8_STAGE(PG8_SB(1, 0), cB + kstep, voffB); PG8_STAGE(PG8_SA(1, 0), cA + kstep, voffA); PG8_STAGE(PG8_SB(1, 1), cB + hstep + kstep, voffB);
        PG8_WAIT_V(6); PG8_BAR;
    }
    for (;;) {
        const bool has_next = S.next(ui + 1, nxt);
        const char* nA = has_next ? (const char*)g.A + (size_t)nxt.pm * tstep : cA; const char* nB = has_next ? (const char*)g.Bt + (size_t)nxt.pn * tstep : cB;
        for (int t = 0; t < nt; t += 2) {
            const bool last = (t == nt - 2);
            const char* a1 = cA + (size_t)(t + 1) * kstep;
            const char* a2 = last ? nA : cA + (size_t)(t + 2) * kstep; const char* b2 = last ? nB : cB + (size_t)(t + 2) * kstep;
            const char* a3 = a2 + kstep; const char* b3 = b2 + kstep;
            if (last && has_next) S.a_ready(nxt);
            if constexpr (SP2) {
            PG8_LDB(B0, 0, 0); PG8_LDB(B1, 0, 1); PG8_SCHED; PG8_LDA(At, 0, 0); PG8_STAGE(PG8_SA(1, 1), a1 + hstep, voffA);
            PG8_WAIT_V(8); PG8_WAIT_L(0); PG8_BAR; PG8_MMA(0, 0, At, B0); PG8_MMA(0, 1, At, B1); PG8_BAR; PG8_SCHED;
            PG8_LDA(At, 0, 1); PG8_STAGE(PG8_SB(0, 0), b2, voffB); PG8_STAGE(PG8_SB(0, 1), b2 + hstep, voffB); PG8_STAGE(PG8_SA(0, 0), a2, voffA);
            PG8_WAIT_V(8); PG8_WAIT_L(0); PG8_BAR; PG8_MMA(1, 0, At, B0); PG8_MMA(1, 1, At, B1); PG8_BAR; PG8_SCHED;
            PG8_LDB(B0, 1, 0); PG8_LDB(B1, 1, 1); PG8_SCHED; PG8_LDA(At, 1, 0); PG8_STAGE(PG8_SA(0, 1), a2 + hstep, voffA);
            PG8_WAIT_V(8); PG8_WAIT_L(0); PG8_BAR; PG8_MMA(0, 0, At, B0); PG8_MMA(0, 1, At, B1); PG8_BAR; PG8_SCHED;
            PG8_LDA(At, 1, 1); PG8_STAGE(PG8_SB(1, 0), b3, voffB); PG8_STAGE(PG8_SB(1, 1), b3 + hstep, voffB); PG8_STAGE(PG8_SA(1, 0), a3, voffA);
            PG8_WAIT_V(8); PG8_WAIT_L(0); PG8_BAR; PG8_MMA(1, 0, At, B0); PG8_MMA(1, 1, At, B1); PG8_BAR; PG8_SCHED;
            } else {
            PG8_LDB(B0, 0, 0); PG8_SCHED; PG8_LDA(At, 0, 0); PG8_STAGE(PG8_SA(1, 1), a1 + hstep, voffA);
            PG8_WAIT_L(8); PG8_BAR; PG8_WAIT_L(0); PG8_MMA(0, 0, At, B0); PG8_BAR; PG8_SCHED;
            PG8_LDB(B1, 0, 1); PG8_STAGE(PG8_SB(0, 0), b2, voffB);
            PG8_BAR; PG8_WAIT_L(0); PG8_MMA(0, 1, At, B1); PG8_BAR;
            PG8_LDA(At, 0, 1); PG8_STAGE(PG8_SA(0, 0), a2, voffA);
            PG8_BAR; PG8_WAIT_L(0); PG8_MMA(1, 0, At, B0); PG8_BAR; PG8_SCHED;
            PG8_STAGE(PG8_SB(0, 1), b2 + hstep, voffB);
            PG8_WAIT_V(6); PG8_BAR; PG8_MMA(1, 1, At, B1); PG8_BAR;
            PG8_LDB(B0, 1, 0); PG8_SCHED; PG8_LDA(At, 1, 0); PG8_STAGE(PG8_SA(0, 1), a2 + hstep, voffA);
            PG8_WAIT_L(8); PG8_BAR; PG8_WAIT_L(0); PG8_MMA(0, 0, At, B0); PG8_BAR; PG8_SCHED;
            PG8_LDB(B1, 1, 1); PG8_STAGE(PG8_SB(1, 0), b3, voffB);
            PG8_BAR; PG8_WAIT_L(0); PG8_MMA(0, 1, At, B1); PG8_BAR;
            PG8_LDA(At, 1, 1); PG8_STAGE(PG8_SA(1, 0), a3, voffA);
            PG8_BAR; PG8_WAIT_L(0); PG8_MMA(1, 0, At, B0); PG8_BAR; PG8_SCHED;
            PG8_STAGE(PG8_SB(1, 1), b3 + hstep, voffB);
            PG8_WAIT_V(6); PG8_BAR; PG8_MMA(1, 1, At, B1); PG8_BAR;
            }
        }
        if constexpr (ALIGN_EPI) { if (wr == 0) PG8_BAR; }
        if constexpr (!Epi::AFTER_DRAIN) { E(acc, cur, wr, wc, fr, fq); S.done(cur); }
        if (!has_next) break;
#pragma unroll
        for (int a = 0; a < 2; ++a)
#pragma unroll
            for (int b = 0; b < 2; ++b)
#pragma unroll
                for (int m = 0; m < 4; ++m)
#pragma unroll
                    for (int n = 0; n < 2; ++n) acc[a][b][m][n] = (f32x4){0.f, 0.f, 0.f, 0.f};
        cur = nxt; cA = nA; cB = nB; ++ui;
        if constexpr (ALIGN_EPI) { if (wr == 1) PG8_BAR; }
    }
    PG8_WAIT_V(0);
    if constexpr (!ALIGN_EPI) { if (wr == 0) PG8_BAR; }
    PG8_BAR;
    if constexpr (Epi::AFTER_DRAIN) { E.fused(acc, cur, wr, wc, fr, fq, lds, wid, lane); S.done(cur); }
#undef PG8_SA
#undef PG8_SB
#undef PG8_STAGE
#undef PG8_LDA
#undef PG8_LDB
#undef PG8_MMA
#undef PG8_WAIT_V
#undef PG8_WAIT_L
#undef PG8_BAR
#undef PG8_SCHED
}
}

constexpr int BATCH = 16, SEQ = 2048, DM = 1024, MTOK = BATCH * SEQ, DFF = 2816, NUP = 2 * DFF, D_IN = 4896, NIN = 5120;
constexpr int NWAVES = 8, NTHREADS = 512;
#define LAS __attribute__((address_space(3)))
typedef pg8::bf16_t bf16_t;
typedef short bf16x8 __attribute__((ext_vector_type(8)));
typedef float f32x4 __attribute__((ext_vector_type(4)));
typedef float f32x16 __attribute__((ext_vector_type(16)));
typedef unsigned u32x4 __attribute__((ext_vector_type(4)));
typedef unsigned u32x2 __attribute__((ext_vector_type(2)));
typedef short s16x4 __attribute__((ext_vector_type(4)));
using pg8::cvt_pk_bf16; using pg8::LOG2E; using pg8::RMS_EPS;

constexpr size_t MiB = 1u << 20, KiB = 1u << 10;
constexpr size_t WS_WUP1 = 1 * MiB, WS_WDN1 = 12 * MiB, WS_WIN = 18 * MiB, WS_WON = 28 * MiB, WS_WOF = 29 * MiB, WS_WOUT = 30 * MiB, WS_WUP2 = 32 * MiB, WS_WDN2 = 43 * MiB;
constexpr size_t WS_CW1K = 49 * MiB, WS_CW1V = 49 * MiB + 512 * KiB, WS_CW2K = 50 * MiB, WS_CW2V = 50 * MiB + 64 * KiB, WS_TAB = 50 * MiB + 128 * KiB, WS_C1 = 50 * MiB + 192 * KiB;
constexpr size_t WS_KCMP = 51 * MiB, WS_VCMP = 51 * MiB + 512 * KiB, WS_SSQ = 52 * MiB, WS_GA = 54 * MiB, WS_LF = 57 * MiB;
constexpr size_t WS_XB = 58 * MiB;
constexpr size_t WS_A = 122 * MiB;
constexpr size_t A_QA = 0, A_KC = 32 * MiB, A_VC = 40 * MiB, A_KS = 48 * MiB, A_VS = 56 * MiB, A_KW = 64 * MiB, A_VW = 72 * MiB, A_QB = 80 * MiB, A_KB = 112 * MiB, A_VB = 144 * MiB, A_GM = 176 * MiB;
constexpr size_t WS_END = 426 * MiB;
constexpr int LDS_BYTES = 147456;

__constant__ unsigned char T5_BUCKET[128] = {0, 1, 2, 3, 4, 5, 6, 7, 8, 9, 10, 11, 12, 13, 14, 15, 16, 16, 16, 17, 17, 18, 18, 18, 19, 19, 19, 20, 20, 20, 20, 21, 21, 21, 21, 22, 22, 22, 22, 22, 23, 23, 23, 23, 23, 23, 24, 24, 24, 24, 24, 24, 25, 25, 25, 25, 25, 25, 25, 26, 26, 26, 26, 26, 26, 26, 26, 27, 27, 27, 27, 27, 27, 27, 27, 27, 27, 28, 28, 28, 28, 28, 28, 28, 28, 28, 28, 29, 29, 29, 29, 29, 29, 29, 29, 29, 29, 29, 29, 30, 30, 30, 30, 30, 30, 30, 30, 30, 30, 30, 30, 30, 30, 31, 31, 31, 31, 31, 31, 31, 31, 31, 31, 31, 31, 31, 31, 31};

struct Args { const float* in[24]; float* out; unsigned char* ws; int ph_lo, ph_hi; };

#define LDS_WAIT() asm volatile("s_waitcnt lgkmcnt(0)" ::: "memory")
__device__ __forceinline__ float wave_sum(float v) {
#pragma unroll
    for (int o = 1; o < 64; o <<= 1) v += __shfl_xor(v, o);
    return v;
}

template <int MODE> __device__ __forceinline__ int src_col(int n) {
    if (MODE == 0) return n;
    if (MODE == 1) { const int pn = n >> 8, bj = (n >> 7) & 1, q = n & 127; return bj * DFF + 128 * pn + q; }
    const int pn = n >> 8, bj = (n >> 7) & 1, wc = (n >> 5) & 3, j = n & 31, L = 256 * pn + 64 * wc + 32 * bj + j;
    if (L < 1280) return L;
    if (L < 2816) return 1304 + (L - 1280);
    if (L < 4864) return 2848 + (L - 2816);
    if (L < 4888) return 1280 + (L - 4864);
    if (L < 4896) return 2840 + (L - 4888);
    return -1;
}
template <int MODE> __device__ __forceinline__ void transpose_item(const float* W, int ldw, int K, int N, const float* ks, bf16_t* WT, LAS float* scr, int item, int lane) {
    const int nblk = N / 32, kb = item / nblk, nb = item % nblk, k0 = 64 * kb, n0 = 32 * nb;
    const int sc = src_col<MODE>(n0 + (lane & 31));
#pragma unroll 8
    for (int i = 0; i < 32; ++i) { const int kk = 2 * i + (lane >> 5); float v = 0.f; if (sc >= 0) v = W[(size_t)(k0 + kk) * ldw + sc]; if (ks) v *= ks[k0 + kk]; scr[kk * 33 + (lane & 31)] = v; }
    LDS_WAIT(); asm volatile("" ::: "memory");
    const int c = lane & 7;
#pragma unroll
    for (int j = 0; j < 4; ++j) { const int n = (lane >> 3) + 8 * j; const LAS float* s = scr + (8 * c) * 33 + n;
        u32x4 o; o.x = cvt_pk_bf16(s[0 * 33], s[1 * 33]); o.y = cvt_pk_bf16(s[2 * 33], s[3 * 33]); o.z = cvt_pk_bf16(s[4 * 33], s[5 * 33]); o.w = cvt_pk_bf16(s[6 * 33], s[7 * 33]);
        *(u32x4*)(WT + (size_t)(n0 + n) * K + k0 + 8 * c) = o; }
    LDS_WAIT(); asm volatile("" ::: "memory");
}

__device__ __forceinline__ void prep_phase(const Args& a, LAS unsigned char* lds, int vcu, int G, int wave, int lane) {
    unsigned char* ws = a.ws;
    LAS float* scr = (LAS float*)(lds + wave * 16384);
    const int gw = vcu * NWAVES + wave, NGW = G * NWAVES;
    constexpr int I_UP = (DM / 64) * (NUP / 32), I_DN = (DFF / 64) * (DM / 32), I_IN = (DM / 64) * (NIN / 32), I_O = (512 / 64) * (DM / 32), I_OUT = (DM / 64) * (DM / 32), I_C1 = (2048 / 64) * (128 / 32), I_C2 = (128 / 64) * (64 / 32);
    constexpr int NITEMS = 2 * I_UP + 2 * I_DN + I_IN + 2 * I_O + I_OUT + 2 * I_C1 + 2 * I_C2;
    for (int it = gw; it < NITEMS; it += NGW) {
        int r = it;
        if (r < I_UP) { transpose_item<1>(a.in[2], NUP, DM, NUP, a.in[1], (bf16_t*)(ws + WS_WUP1), scr, r, lane); continue; } r -= I_UP;
        if (r < I_UP) { transpose_item<1>(a.in[21], NUP, DM, NUP, a.in[20], (bf16_t*)(ws + WS_WUP2), scr, r, lane); continue; } r -= I_UP;
        if (r < I_DN) { transpose_item<0>(a.in[3], DM, DFF, DM, nullptr, (bf16_t*)(ws + WS_WDN1), scr, r, lane); continue; } r -= I_DN;
        if (r < I_DN) { transpose_item<0>(a.in[22], DM, DFF, DM, nullptr, (bf16_t*)(ws + WS_WDN2), scr, r, lane); continue; } r -= I_DN;
        if (r < I_IN) { transpose_item<2>(a.in[5], D_IN, DM, NIN, a.in[4], (bf16_t*)(ws + WS_WIN), scr, r, lane); continue; } r -= I_IN;
        if (r < I_O) { transpose_item<0>(a.in[17], DM, 512, DM, nullptr, (bf16_t*)(ws + WS_WON), scr, r, lane); continue; } r -= I_O;
        if (r < I_O) { transpose_item<0>(a.in[18], DM, 512, DM, nullptr, (bf16_t*)(ws + WS_WOF), scr, r, lane); continue; } r -= I_O;
        if (r < I_OUT) { transpose_item<0>(a.in[19], DM, DM, DM, nullptr, (bf16_t*)(ws + WS_WOUT), scr, r, lane); continue; } r -= I_OUT;
        if (r < I_C1) { transpose_item<0>(a.in[13], 128, 2048, 128, nullptr, (bf16_t*)(ws + WS_CW1K), scr, r, lane); continue; } r -= I_C1;
        if (r < I_C1) { transpose_item<0>(a.in[15], 128, 2048, 128, nullptr, (bf16_t*)(ws + WS_CW1V), scr, r, lane); continue; } r -= I_C1;
        if (r < I_C2) { transpose_item<0>(a.in[14], 64, 128, 64, nullptr, (bf16_t*)(ws + WS_CW2K), scr, r, lane); continue; } r -= I_C2;
        transpose_item<0>(a.in[16], 64, 128, 64, nullptr, (bf16_t*)(ws + WS_CW2V), scr, r, lane);
    }
    const float* x = a.in[0]; bf16_t* XB = (bf16_t*)(ws + WS_XB); float* SSQ = (float*)(ws + WS_SSQ);
    for (int m = gw; m < MTOK; m += NGW) {
        const f32x4* xr = (const f32x4*)(x + (size_t)m * DM) + lane; f32x4 v[4]; float s = 0.f;
#pragma unroll
        for (int j = 0; j < 4; ++j) { v[j] = xr[64 * j]; s += (v[j][0] * v[j][0] + v[j][1] * v[j][1]) + (v[j][2] * v[j][2] + v[j][3] * v[j][3]); }
        s = wave_sum(s);
        u32x2* o8 = (u32x2*)(XB + (size_t)m * DM) + lane;
#pragma unroll
        for (int j = 0; j < 4; ++j) { u32x2 w; w.x = cvt_pk_bf16(v[j][0], v[j][1]); w.y = cvt_pk_bf16(v[j][2], v[j][3]); o8[64 * j] = w; }
        if (lane < 16) SSQ[(size_t)m * 16 + lane] = (lane == 0) ? s : 0.f;
    }
    { float* TAB = (float*)(ws + WS_TAB); const float* tbl = a.in[23];
      for (int i = gw * 64 + lane; i < 8 * 128; i += NGW * 64) { const int h = i >> 7, d = i & 127; TAB[i] = tbl[(int)T5_BUCKET[d] * 8 + h] * LOG2E; } }
    { float* C1 = (float*)(ws + WS_C1);
      for (int o = gw; o < 256; o += NGW) { const int kv = o >> 7, n = o & 127; const float* pos = a.in[11 + kv]; const float* w1 = a.in[13 + 2 * kv]; float s = 0.f;
          for (int k = lane; k < 2048; k += 64) s += pos[k] * w1[(size_t)k * 128 + n];
          s = wave_sum(s); if (lane == 0) C1[o] = s; } }
}

constexpr int KVP = 144, KVT = 64 * KVP;
constexpr float NEG = -1.0e30f;
__device__ __forceinline__ int crow(int r, int h) { return (r & 3) + 8 * (r >> 2) + 4 * h; }
#define MFMA32(a, b, c) __builtin_amdgcn_mfma_f32_32x32x16_bf16((a), (b), (c), 0, 0, 0)
typedef short v4i16_t __attribute__((ext_vector_type(4)));
__device__ __forceinline__ s16x4 vtr(LAS const unsigned char* p) { return __builtin_bit_cast(s16x4, __builtin_amdgcn_ds_read_tr16_b64_v4i16((LAS v4i16_t*)p)); }

__device__ __forceinline__ void qk_tile(f32x16& p0, f32x16& p1, LAS const unsigned char* Kt, const bf16x8 (&qf)[4], int lane) {
    LAS const unsigned char* kp = Kt + (lane & 31) * KVP + 16 * (lane >> 5);
    f32x16 z = {}; p0 = z; p1 = z;
#pragma unroll
    for (int s = 0; s < 4; ++s) { const bf16x8 a0 = *(LAS const bf16x8*)(kp + 32 * s), a1 = *(LAS const bf16x8*)(kp + 32 * KVP + 32 * s);
        p0 = MFMA32(a0, qf[s], p0); p1 = MFMA32(a1, qf[s], p1); }
}
__device__ __forceinline__ void pv_tile(f32x16& o0, f32x16& o1, LAS const unsigned char* Vt, const bf16x8 (&pf)[4], int lane) {
    LAS const unsigned char* vp = Vt + (4 * (lane >> 5) + ((lane & 15) >> 2)) * KVP + (16 * ((lane >> 4) & 1) + 4 * (lane & 3)) * 2;
#pragma unroll
    for (int s = 0; s < 4; ++s) {
        const s16x4 l0 = vtr(vp + (16 * s) * KVP), h0 = vtr(vp + (16 * s + 8) * KVP), l1 = vtr(vp + (16 * s) * KVP + 64), h1 = vtr(vp + (16 * s + 8) * KVP + 64);
        const bf16x8 v0 = {l0[0], l0[1], l0[2], l0[3], h0[0], h0[1], h0[2], h0[3]}, v1 = {l1[0], l1[1], l1[2], l1[3], h1[0], h1[1], h1[2], h1[3]};
        o0 = MFMA32(v0, pf[s], o0); o1 = MFMA32(v1, pf[s], o1); }
}
__device__ __forceinline__ void pack_p(bf16x8 (&pf)[4], const f32x16& p0, const f32x16& p1) {
#pragma unroll
    for (int s = 0; s < 4; ++s) { const f32x16& p = (s < 2) ? p0 : p1; const int b = 8 * (s & 1);
        u32x4 w; w.x = cvt_pk_bf16(p[b], p[b + 1]); w.y = cvt_pk_bf16(p[b + 2], p[b + 3]); w.z = cvt_pk_bf16(p[b + 4], p[b + 5]); w.w = cvt_pk_bf16(p[b + 6], p[b + 7]);
        pf[s] = __builtin_bit_cast(bf16x8, w); }
}
struct FState { f32x16 o0, o1; float m, l; };
__device__ __forceinline__ void fstate_init(FState& st) { f32x16 z = {}; st.o0 = z; st.o1 = z; st.m = NEG; st.l = 0.f; }
__device__ __forceinline__ void softmax_pv(FState& st, f32x16& p0, f32x16& p1, LAS const unsigned char* Vt, int lane) {
    float mx = fmaxf(p0[0], p1[0]);
#pragma unroll
    for (int r = 1; r < 16; ++r) mx = fmaxf(mx, fmaxf(p0[r], p1[r]));
    mx = fmaxf(mx, __shfl_xor(mx, 32));
    const float mn = fmaxf(st.m, mx), alpha = __builtin_amdgcn_exp2f(st.m - mn);
    float sum = 0.f;
#pragma unroll
    for (int r = 0; r < 16; ++r) { const float e0 = (p0[r] > -1.0e29f) ? __builtin_amdgcn_exp2f(p0[r] - mn) : 0.f, e1 = (p1[r] > -1.0e29f) ? __builtin_amdgcn_exp2f(p1[r] - mn) : 0.f;
        p0[r] = e0; p1[r] = e1; sum += e0 + e1; }
    st.l = st.l * alpha + sum; st.m = mn; st.o0 *= alpha; st.o1 *= alpha;
    bf16x8 pf[4]; pack_p(pf, p0, p1);
    pv_tile(st.o0, st.o1, Vt, pf, lane);
}
__device__ __forceinline__ u32x4 tile_ld(const bf16_t* base, int pitch, int tid) { return *(const u32x4*)(base + (size_t)(tid >> 3) * pitch + (tid & 7) * 8); }
__device__ __forceinline__ void tile_st(LAS unsigned char* T, u32x4 v, int tid) { *(LAS u32x4*)(T + (tid >> 3) * KVP + (tid & 7) * 16) = v; }

template <int MODE> __device__ __forceinline__ void flash_loop(FState& st, unsigned tiles, const bf16_t* Kg, const bf16_t* Vg, int pitch, LAS unsigned char* kvb, const bf16x8 (&qf)[4],
                                                               LAS const float* aux, int t, int R0, unsigned selbits, int tq, int tid, int lane) {
    if (tiles == 0u) return;
    const int h = lane >> 5;
    int cur = 0;
    { const int j0 = __builtin_ctz(tiles); const u32x4 k = tile_ld(Kg + (size_t)(64 * j0) * pitch, pitch, tid), v = tile_ld(Vg + (size_t)(64 * j0) * pitch, pitch, tid);
      tile_st(kvb, k, tid); tile_st(kvb + KVT, v, tid); }
    __syncthreads();
    float cq = 0.f; if (MODE == 0) cq = aux[t];
    while (tiles) {
        const int j = __builtin_ctz(tiles); tiles &= tiles - 1u;
        u32x4 kn = {}, vn = {};
        if (tiles) { const int jn = __builtin_ctz(tiles); kn = tile_ld(Kg + (size_t)(64 * jn) * pitch, pitch, tid); vn = tile_ld(Vg + (size_t)(64 * jn) * pitch, pitch, tid); }
        LAS unsigned char* Kt = kvb + cur * 2 * KVT; LAS unsigned char* Vt = Kt + KVT;
        bool act;
        if (MODE == 0) act = (64 * j <= R0 + 31);
        else if (MODE == 1) act = __any((selbits >> j) & 1u);
        else act = true;
        if (act) {
            f32x16 p0, p1; qk_tile(p0, p1, Kt, qf, lane);
            const int kb = 64 * j + 4 * h;
            if (MODE == 0) {
#pragma unroll
                for (int g4 = 0; g4 < 4; ++g4) { const f32x4 c0 = *(LAS const f32x4*)(aux + kb + 8 * g4), c1 = *(LAS const f32x4*)(aux + kb + 8 * g4 + 32);
#pragma unroll
                    for (int i = 0; i < 4; ++i) { p0[4 * g4 + i] += cq - c0[i]; p1[4 * g4 + i] += cq - c1[i]; } }
                if (64 * j + 63 > R0) {
#pragma unroll
                    for (int r = 0; r < 16; ++r) { const int kp = kb + (r & 3) + 8 * (r >> 2); if (kp > t) p0[r] = NEG; if (kp + 32 > t) p1[r] = NEG; } }
            } else {
                if (j + 3 <= tq) { const float c31 = aux[127];
#pragma unroll
                    for (int r = 0; r < 16; ++r) { p0[r] += c31; p1[r] += c31; }
                } else {
#pragma unroll
                    for (int r = 0; r < 16; ++r) { const int d0 = t - (kb + (r & 3) + 8 * (r >> 2)), d1 = d0 - 32;
                        p0[r] += aux[min(max(d0, 0), 127)]; p1[r] += aux[min(max(d1, 0), 127)]; }
                }
                if (MODE == 1) {
                    const bool sel = (selbits >> j) & 1u;
                    if (j == tq) {
#pragma unroll
                        for (int r = 0; r < 16; ++r) { const int kp = kb + (r & 3) + 8 * (r >> 2); if (!sel || kp > t) p0[r] = NEG; if (!sel || kp + 32 > t) p1[r] = NEG; }
                    } else {
#pragma unroll
                        for (int r = 0; r < 16; ++r) { if (!sel) { p0[r] = NEG; p1[r] = NEG; } }
                    }
                } else {
                    if (j == tq || j + 8 == tq) {
#pragma unroll
                        for (int r = 0; r < 16; ++r) { const int d0 = t - (kb + (r & 3) + 8 * (r >> 2)), d1 = d0 - 32; if (d0 < 0 || d0 >= 512) p0[r] = NEG; if (d1 < 0 || d1 >= 512) p1[r] = NEG; }
                    }
                }
            }
            softmax_pv(st, p0, p1, Vt, lane);
        }
        if (tiles) { LAS unsigned char* Kn = kvb + (cur ^ 1) * 2 * KVT; tile_st(Kn, kn, tid); tile_st(Kn + KVT, vn, tid); }
        __syncthreads();
        cur ^= 1;
    }
}
__device__ __forceinline__ void store_ot(bf16_t* orow, const f32x16& o0, const f32x16& o1, int h) {
#pragma unroll
    for (int g4 = 0; g4 < 4; ++g4) { u32x2 w0, w1; w0.x = cvt_pk_bf16(o0[4 * g4], o0[4 * g4 + 1]); w0.y = cvt_pk_bf16(o0[4 * g4 + 2], o0[4 * g4 + 3]); w1.x = cvt_pk_bf16(o1[4 * g4], o1[4 * g4 + 1]); w1.y = cvt_pk_bf16(o1[4 * g4 + 2], o1[4 * g4 + 3]);
        *(u32x2*)(orow + 8 * g4 + 4 * h) = w0; *(u32x2*)(orow + 32 + 8 * g4 + 4 * h) = w1; }
}

__device__ __forceinline__ void compress_unit(int U, const Args& a, LAS unsigned char* lds, int tid, int wave, int lane) {
    unsigned char* ws = a.ws;
    const int kv = U & 1, ct = (U >> 1) & 3, g = (U >> 3) & 1, b = U >> 4;
    const bf16_t* SRC = (const bf16_t*)(ws + WS_A + (kv ? A_VC : A_KC));
    const bf16_t* W1T = (const bf16_t*)(ws + (kv ? WS_CW1V : WS_CW1K));
    const bf16_t* W2T = (const bf16_t*)(ws + (kv ? WS_CW2V : WS_CW2K));
    const float* C1 = (const float*)(ws + WS_C1) + 128 * kv;
    bf16_t* DST = (bf16_t*)(ws + (kv ? WS_VCMP : WS_KCMP)) + (size_t)((b * 2 + g) * 128 + 32 * ct) * 64;
    LAS float* hid = (LAS float*)lds;
    LAS unsigned char* hb = lds + 16640;
    LAS float* out2 = (LAS float*)(lds + 16640 + 8704);
    const int nt = wave & 3, kh = wave >> 2, i = lane & 31, h = lane >> 5;
    const int c = min(32 * ct + i, 126);
    const bf16_t* arow = SRC + (size_t)(b * SEQ + 16 * c + 16 * kh) * 128 + 64 * g + 8 * h;
    const bf16_t* brow = W1T + (size_t)(32 * nt + i) * 2048 + (16 * kh) * 64 + 8 * h;
    f32x16 acc = {};
#pragma unroll 4
    for (int lt = 0; lt < 16; ++lt)
#pragma unroll
        for (int s = 0; s < 4; ++s) { const bf16x8 av = *(const bf16x8*)(arow + lt * 128 + 16 * s), bv = *(const bf16x8*)(brow + lt * 64 + 16 * s); acc = MFMA32(av, bv, acc); }
    if (kh == 1) {
#pragma unroll
        for (int r = 0; r < 16; ++r) hid[crow(r, h) * 129 + 32 * nt + i] = acc[r];
    }
    __syncthreads();
    if (kh == 0) { const float c1 = C1[32 * nt + i];
#pragma unroll
        for (int r = 0; r < 16; ++r) { const float v = acc[r] + hid[crow(r, h) * 129 + 32 * nt + i] + c1; const float sv = pg8::silu_f(v);
            *(LAS bf16_t*)(hb + crow(r, h) * 272 + (32 * nt + i) * 2) = (bf16_t)(cvt_pk_bf16(sv, 0.f) & 0xffffu); }
    }
    __syncthreads();
    if (wave < 2) { f32x16 a2 = {};
#pragma unroll
        for (int s = 0; s < 8; ++s) { const bf16x8 av = *(LAS const bf16x8*)(hb + i * 272 + (16 * s + 8 * h) * 2), bv = *(const bf16x8*)(W2T + (size_t)(32 * wave + i) * 128 + 16 * s + 8 * h); a2 = MFMA32(av, bv, a2); }
#pragma unroll
        for (int r = 0; r < 16; ++r) out2[crow(r, h) * 65 + 32 * wave + i] = a2[r];
    }
    __syncthreads();
    { const int cl = tid >> 4, e4 = (tid & 15) * 4; float v[4]; float ss = 0.f;
#pragma unroll
      for (int q = 0; q < 4; ++q) { v[q] = out2[cl * 65 + e4 + q]; ss += v[q] * v[q]; }
      if (kv == 0) { ss += __shfl_xor(ss, 1); ss += __shfl_xor(ss, 2); ss += __shfl_xor(ss, 4); ss += __shfl_xor(ss, 8);
          const float rs = __builtin_amdgcn_rsqf(ss * (1.0f / 64.0f) + RMS_EPS); const float* gn = a.in[8];
#pragma unroll
          for (int q = 0; q < 4; ++q) v[q] = v[q] * rs * gn[e4 + q]; }
      if (32 * ct + cl >= 127) { v[0] = 0.f; v[1] = 0.f; v[2] = 0.f; v[3] = 0.f; }
      u32x2 w; w.x = cvt_pk_bf16(v[0], v[1]); w.y = cvt_pk_bf16(v[2], v[3]); *(u32x2*)(DST + (size_t)cl * 64 + e4) = w; }
    __syncthreads();
}

__device__ __forceinline__ void fox_unit(int b, int hh, int qb, const Args& a, LAS unsigned char* lds, int tid, int wave, int lane) {
    unsigned char* ws = a.ws;
    const bf16_t* QB = (const bf16_t*)(ws + WS_A + A_QB); const bf16_t* KB = (const bf16_t*)(ws + WS_A + A_KB); const bf16_t* VB = (const bf16_t*)(ws + WS_A + A_VB);
    const float* LF = (const float*)(ws + WS_LF); bf16_t* OF = (bf16_t*)(ws + WS_XB + 32 * MiB);
    LAS float* cum2 = (LAS float*)(lds + 4 * KVT); LAS float* wsum = (LAS float*)(lds + 4 * KVT + 8192);
    const int nrows = 256 * (qb + 1), h = lane >> 5;
    { float v[4];
#pragma unroll
      for (int i = 0; i < 4; ++i) { const int s = 4 * tid + i; v[i] = (s < nrows) ? LF[(size_t)(b * SEQ + s) * 8 + hh] : 0.f; }
      v[1] += v[0]; v[2] += v[1]; v[3] += v[2];
      float tot = v[3];
#pragma unroll
      for (int off = 1; off < 64; off <<= 1) { const float tt = __shfl_up(tot, off); if (lane >= off) tot += tt; }
      if (lane == 63) wsum[wave] = tot;
      __syncthreads();
      float base = 0.f;
      for (int i = 0; i < wave; ++i) base += wsum[i];
      const float excl = (tot - v[3]) + base;
#pragma unroll
      for (int i = 0; i < 4; ++i) cum2[4 * tid + i] = (v[i] + excl) * LOG2E;
      __syncthreads(); }
    const int R0 = 256 * qb + 32 * wave, t = R0 + (lane & 31); const size_t row = (size_t)b * SEQ + t;
    bf16x8 qf[4];
#pragma unroll
    for (int s = 0; s < 4; ++s) qf[s] = *(const bf16x8*)(QB + row * 512 + hh * 64 + 16 * s + 8 * h);
    FState st; fstate_init(st);
    const unsigned tiles = (qb == 7) ? 0xffffffffu : ((1u << (4 * qb + 4)) - 1u);
    flash_loop<0>(st, tiles, KB + (size_t)b * SEQ * 512 + hh * 64, VB + (size_t)b * SEQ * 512 + hh * 64, 512, lds, qf, cum2, t, R0, 0u, 0, tid, lane);
    float l = st.l + __shfl_xor(st.l, 32); const float inv = (l > 0.f) ? 1.0f / l : 0.f;
    st.o0 *= inv; st.o1 *= inv;
    store_ot(OF + row * 512 + hh * 64, st.o0, st.o1, h);
    __syncthreads();
}

constexpr int NL_CMP = 4 * KVT, NL_IMP = 8 * KVT, NL_SEL = NL_IMP + 4 * 64 * 33 * 4, NL_UNI = NL_SEL + 256, NL_TAB = NL_SEL + 512;
__device__ __forceinline__ void nsa_unit(int b, int g, int tq, const Args& a, LAS unsigned char* lds, int tid, int wave, int lane) {
    unsigned char* ws = a.ws;
    const bf16_t* QA = (const bf16_t*)(ws + WS_A + A_QA);
    const bf16_t* KS = (const bf16_t*)(ws + WS_A + A_KS); const bf16_t* VS = (const bf16_t*)(ws + WS_A + A_VS);
    const bf16_t* KW = (const bf16_t*)(ws + WS_A + A_KW); const bf16_t* VW = (const bf16_t*)(ws + WS_A + A_VW);
    const bf16_t* KCM = (const bf16_t*)(ws + WS_KCMP) + (size_t)(b * 2 + g) * 128 * 64; const bf16_t* VCM = (const bf16_t*)(ws + WS_VCMP) + (size_t)(b * 2 + g) * 128 * 64;
    const float* GA = (const float*)(ws + WS_GA); bf16_t* ON = (bf16_t*)(ws + WS_XB);
    LAS unsigned char* cmpb = lds + NL_CMP;
    LAS float* imp = (LAS float*)(lds + NL_IMP);
    LAS unsigned* selm = (LAS unsigned*)(lds + NL_SEL); LAS unsigned* uni = (LAS unsigned*)(lds + NL_UNI);
    const int hr = wave >> 1, th = wave & 1, head = 4 * g + hr, h = lane >> 5, tl = 32 * th + (lane & 31), t = 64 * tq + tl;
    const size_t row = (size_t)b * SEQ + t;
    LAS const float* tabh = (LAS const float*)(lds + NL_TAB) + 128 * head;
    bf16x8 qf[4];
#pragma unroll
    for (int s = 0; s < 4; ++s) qf[s] = *(const bf16x8*)(QA + row * 512 + head * 64 + 16 * s + 8 * h);
    const int nct = (4 * tq + 3 > 64) ? 2 : 1;
    for (int i = 0; i < nct; ++i) { tile_st(cmpb + i * KVT, tile_ld(KCM + (size_t)i * 64 * 64, 64, tid), tid); tile_st(cmpb + (2 + i) * KVT, tile_ld(VCM + (size_t)i * 64 * 64, 64, tid), tid); }
    if (tid == 0) uni[0] = 0u;
    __syncthreads();
    f32x16 acc0, acc1;
    {
#define CMP_LOGITS(ti) do { qk_tile(p0, p1, cmpb + (ti) * KVT, qf, lane); \
            _Pragma("unroll") for (int r = 0; r < 16; ++r) { const int c = 64 * (ti) + crow(r, h); const int d0 = t - (16 * c + 31), d1 = d0 - 512; \
                p0[r] = (d0 >= 0) ? p0[r] + tabh[min(d0, 127)] : NEG; p1[r] = (d1 >= 0) ? p1[r] + tabh[min(d1, 127)] : NEG; } } while (0)
        f32x16 p0, p1; float mx = NEG, sum = 0.f;
#define CMP_PASS1(ti) do { CMP_LOGITS(ti); float tm = fmaxf(p0[0], p1[0]); _Pragma("unroll") for (int r = 1; r < 16; ++r) tm = fmaxf(tm, fmaxf(p0[r], p1[r])); \
            tm = fmaxf(tm, __shfl_xor(tm, 32)); const float mn = fmaxf(mx, tm); float sacc = 0.f; \
            _Pragma("unroll") for (int r = 0; r < 16; ++r) { sacc += ((p0[r] > -1.0e29f) ? __builtin_amdgcn_exp2f(p0[r] - mn) : 0.f) + ((p1[r] > -1.0e29f) ? __builtin_amdgcn_exp2f(p1[r] - mn) : 0.f); } \
            sum = sum * __builtin_amdgcn_exp2f(mx - mn) + sacc; mx = mn; } while (0)
        CMP_PASS1(0);
        if (nct > 1) CMP_PASS1(1);
        sum += __shfl_xor(sum, 32);
        const float inv = (sum > 0.f) ? 1.0f / sum : 0.f;
        f32x16 z = {}; acc0 = z; acc1 = z;
        LAS float* ip = imp + (hr * 64 + tl) * 33 + h; float carry = 0.f;
#define IMP_TILE(P, T) _Pragma("unroll") for (int qd = 0; qd < 4; ++qd) { const float own = (P[4 * qd] + P[4 * qd + 1]) + (P[4 * qd + 2] + P[4 * qd + 3]); const float rc = __shfl_xor(P[4 * qd + 3], 32); \
              ip[2 * (4 * (T) + qd)] = own + (h ? rc : carry); carry = rc; }
#define CMP_PASS2(ti) do { CMP_LOGITS(ti); \
            _Pragma("unroll") for (int r = 0; r < 16; ++r) { p0[r] = (p0[r] > -1.0e29f) ? __builtin_amdgcn_exp2f(p0[r] - mx) * inv : 0.f; p1[r] = (p1[r] > -1.0e29f) ? __builtin_amdgcn_exp2f(p1[r] - mx) * inv : 0.f; } \
            IMP_TILE(p0, 2 * (ti)) IMP_TILE(p1, 2 * (ti) + 1) \
            bf16x8 pf[4]; pack_p(pf, p0, p1); pv_tile(acc0, acc1, cmpb + (2 + (ti)) * KVT, pf, lane); } while (0)
        CMP_PASS2(0);
        if (nct > 1) CMP_PASS2(1);
#undef CMP_LOGITS
#undef CMP_PASS1
#undef CMP_PASS2
#undef IMP_TILE
        const float g_c = GA[row * 24 + head];
        acc0 *= g_c; acc1 *= g_c;
    }
    __syncthreads();
    if (tid < 64) {
        LAS float* r0 = imp + tid * 33;
        for (int j = 0; j <= tq; ++j) { float s = (r0[j] + imp[(64 + tid) * 33 + j]) + (imp[(128 + tid) * 33 + j] + imp[(192 + tid) * 33 + j]); r0[j] = s; }
        unsigned sel = 1u | (1u << tq); if (tq > 0) sel |= 1u << (tq - 1);
        const int need = 8 - __builtin_popcount(sel);
        for (int it = 0; it < need; ++it) { int best = -1; float bv = -3.0e38f;
            for (int j = 0; j <= tq; ++j) { if (!((sel >> j) & 1u)) { const float v = r0[j]; if (v > bv) { bv = v; best = j; } } }
            if (best >= 0) sel |= 1u << best; }
        selm[tid] = sel; atomicOr((unsigned*)uni, sel);
    }
    __syncthreads();
    const unsigned selbits = selm[tl], utiles = uni[0];
    { FState st; fstate_init(st);
      flash_loop<1>(st, utiles, KS + (size_t)b * SEQ * 128 + 64 * g, VS + (size_t)b * SEQ * 128 + 64 * g, 128, lds, qf, tabh, t, 0, selbits, tq, tid, lane);
      float l = st.l + __shfl_xor(st.l, 32); int l2 = lane; asm volatile("" : "+v"(l2)); const size_t row2 = (size_t)b * SEQ + 64 * tq + 32 * th + (l2 & 31);
      const float g_s = GA[row2 * 24 + 8 + head]; const float sc = (l > 0.f) ? g_s / l : 0.f;
      acc0 += st.o0 * sc; acc1 += st.o1 * sc; }
    { FState st; fstate_init(st);
      const int jlo = max(tq - 8, 0); const unsigned hi = (tq == 31) ? 0xffffffffu : ((1u << (tq + 1)) - 1u); const unsigned wt = hi & ~((1u << jlo) - 1u);
      flash_loop<2>(st, wt, KW + (size_t)b * SEQ * 128 + 64 * g, VW + (size_t)b * SEQ * 128 + 64 * g, 128, lds, qf, tabh, t, 0, 0u, tq, tid, lane);
      float l = st.l + __shfl_xor(st.l, 32); int l2 = lane; asm volatile("" : "+v"(l2)); const size_t row2 = (size_t)b * SEQ + 64 * tq + 32 * th + (l2 & 31);
      const float g_w = GA[row2 * 24 + 16 + head]; const float sc = (l > 0.f) ? g_w / l : 0.f;
      acc0 += st.o0 * sc; acc1 += st.o1 * sc;
      store_ot(ON + row2 * 512 + head * 64, acc0, acc1, l2 >> 5); }
    __syncthreads();
}
#define XB_TMO      128
#define XB_XCNT(j)  (256  + 64 * (j))
#define XB_XSUB(j)  (1280 + 64 * (j))
#define XB_XGEN(j)  (2304 + 64 * (j))
#define XB_TOP      3328
#define XB_TOPGEN   3392
#define XCD_BAR_WORDS 3456
#define XB_SPIN_CAP (1u << 18)

__device__ __forceinline__ unsigned xb_ld(unsigned* p)              { return __hip_atomic_load(p, __ATOMIC_RELAXED, __HIP_MEMORY_SCOPE_AGENT); }
__device__ __forceinline__ unsigned xb_add(unsigned* p, unsigned v) { return __hip_atomic_fetch_add(p, v, __ATOMIC_RELAXED, __HIP_MEMORY_SCOPE_AGENT); }
__device__ __forceinline__ unsigned xb_xcc_id() { return (unsigned)__builtin_amdgcn_s_getreg((3 << 11) | 20) & 0xFu; }
#define XB_SPIN(cond, bar) do { unsigned _sp = 0; while (cond) { __builtin_amdgcn_s_sleep(1); \
    if ((++_sp & 255u) == 0u) { if (xb_ld(&(bar)[XB_TMO])) break; if (_sp > XB_SPIN_CAP) { atomicAdd(&(bar)[XB_TMO], 1u); break; } } } } while (0)

struct XcdBarrier {
    unsigned* bar; unsigned x;
    volatile LAS unsigned* st;
};

__device__ __forceinline__ XcdBarrier xcd_barrier_post(unsigned* bar, volatile LAS unsigned* st, int tid) {
    XcdBarrier b; b.bar = bar; b.x = xb_xcc_id(); b.st = st;
    if (tid == 0) (void)xb_add(&bar[XB_XCNT(b.x)], 1u);
    return b;
}
__device__ __forceinline__ void xcd_barrier_complete(unsigned* bar, unsigned x, unsigned& nloc, unsigned& nx) {
    const unsigned G = gridDim.x;
    unsigned sum, cnt, mine, sp = 0u;
    for (;;) {
        sum = 0u; cnt = 0u; mine = 0u;
#pragma unroll
        for (unsigned j = 0; j < 16; ++j) { const unsigned c = xb_ld(&bar[XB_XCNT(j)]); sum += c; cnt += (c > 0u) ? 1u : 0u; mine = (j == x) ? c : mine; }
        if (sum == G) break;
        __builtin_amdgcn_s_sleep(1);
        if ((++sp & 255u) == 0u) { if (xb_ld(&bar[XB_TMO])) break; if (sp > XB_SPIN_CAP) { atomicAdd(&bar[XB_TMO], 1u); break; } }
    }
    nloc = mine > 0u ? mine : 1u; nx = cnt > 0u ? cnt : 1u;
}

__device__ __forceinline__ void xcd_barrier(const XcdBarrier& b, int tid) {
    asm volatile("s_waitcnt vmcnt(0)" ::: "memory");
    __syncthreads();
    if (tid == 0) {
        unsigned* bar = b.bar;
        __builtin_amdgcn_s_waitcnt(0);
        unsigned nloc = b.st[0], nx = b.st[1];
        if (nloc == 0u) { xcd_barrier_complete(bar, b.x, nloc, nx); b.st[0] = nloc; b.st[1] = nx; }
        const unsigned old = xb_add(&bar[XB_XSUB(b.x)], 1u);
        const unsigned gen = old / nloc;
        if (old + 1u == (gen + 1u) * nloc) {
            __builtin_amdgcn_fence(__ATOMIC_RELEASE, "agent");
            asm volatile("s_waitcnt vmcnt(0)" ::: "memory");
            const unsigned og = xb_add(&bar[XB_TOP], 1u);
            const unsigned tg = og / nx;
            if (og + 1u == (tg + 1u) * nx) xb_add(&bar[XB_TOPGEN], 1u);
            else XB_SPIN(xb_ld(&bar[XB_TOPGEN]) == tg, bar);
            __builtin_amdgcn_fence(__ATOMIC_ACQUIRE, "agent");
            xb_add(&bar[XB_XGEN(b.x)], 1u);
            asm volatile("s_waitcnt vmcnt(0)" ::: "memory");
        } else {
            XB_SPIN(xb_ld(&bar[XB_XGEN(b.x)]) == gen, bar);
            __builtin_amdgcn_fence(__ATOMIC_ACQUIRE, "agent");
            asm volatile("s_waitcnt vmcnt(0)" ::: "memory");
        }
    }
    __syncthreads();
}

constexpr int NPHASE = 11;
#ifndef PHMASK
#define PHMASK 0xfff
#endif
#ifndef MK_MULTI_LAUNCH
#define MK_MULTI_LAUNCH 0
#endif
__global__ void __launch_bounds__(NTHREADS, 2) fwd_kernel(Args a) {
    extern __shared__ __attribute__((aligned(16))) unsigned char lds_raw[];
    LAS unsigned char* lds = (LAS unsigned char*)lds_raw;
    const int G = gridDim.x, bx = blockIdx.x, vcu = (G % 8 == 0) ? (bx % 8) * (G / 8) + bx / 8 : bx;
    unsigned char* const ws = a.ws;
#define P_XB ((bf16_t*)(ws + WS_XB))
#define P_HB ((bf16_t*)(ws + WS_A))
#define P_MERGED ((bf16_t*)(ws + WS_A))
#define P_SSQ ((float*)(ws + WS_SSQ))
#define P_GM ((bf16_t*)(ws + WS_A + A_GM))
    const int lo = a.ph_lo, hi = a.ph_hi;
    const int wave_s = __builtin_amdgcn_readfirstlane(threadIdx.x >> 6);
#define MYTID() (wave_s * 64 + (int)__builtin_amdgcn_mbcnt_hi(~0u, __builtin_amdgcn_mbcnt_lo(~0u, 0u)))
#define IN(k) (lo <= (k) && (k) < hi)

#define GRID_BARRIER() do { XcdBarrier bar_; bar_.bar = (unsigned*)ws; bar_.x = xb_xcc_id(); bar_.st = (volatile LAS unsigned*)(lds + 131072); xcd_barrier(bar_, MYTID()); } while (0)
#define SYNC_AFTER(k) do { if (IN(k) && IN((k) + 1)) GRID_BARRIER(); } while (0)
#define OPAQUE_TID() int tid = MYTID(); asm volatile("" : "+v"(tid)); const int lane = tid & 63, wave = __builtin_amdgcn_readfirstlane(tid >> 6); (void)lane; (void)wave
#define GEMM_SWIGLU(k, WOFF) if (IN(k)) { pg8::Gemm g{P_XB, (const bf16_t*)(ws + (WOFF)), MTOK, NUP, DM}; pg8::StaticOrder S; S.init(MTOK, NUP, G, bx); pg8::EpiSwiGLU E{P_HB, DFF, P_SSQ}; \
        pg8::gemm_phase<pg8::EpiSwiGLU, pg8::StaticOrder, true, true>(lds, g, S, E, MYTID()); }
#define GEMM_RESID(k, APTR, WOFF, KDIM, BASE, ALPHA, XBP, SSQP) if (IN(k)) { pg8::Gemm g{(APTR), (const bf16_t*)(ws + (WOFF)), MTOK, DM, (KDIM)}; pg8::StaticOrder S; S.init(MTOK, DM, G, bx); \
        pg8::EpiResid E{(BASE), a.out, (ALPHA), (XBP), (SSQP)}; pg8::gemm_phase<pg8::EpiResid, pg8::StaticOrder, true, true>(lds, g, S, E, MYTID()); }
#define GEMM_GATE(k, APTR, WOFF, GOFF, FIRST) if (IN(k)) { pg8::Gemm g{(APTR), (const bf16_t*)(ws + (WOFF)), MTOK, DM, 512}; pg8::StaticOrder S; S.init(MTOK, DM, G, bx); \
        pg8::EpiGate E{P_MERGED, P_GM, (GOFF), (FIRST)}; pg8::gemm_phase<pg8::EpiGate, pg8::StaticOrder, true, true>(lds, g, S, E, MYTID()); }
    { volatile LAS unsigned* stw = (volatile LAS unsigned*)(lds + 131072); if (threadIdx.x == 0) { stw[0] = 0u; stw[1] = 0u; } __syncthreads(); }
    (void)xcd_barrier_post((unsigned*)ws, (volatile LAS unsigned*)(lds + 131072), (int)threadIdx.x);
    if (IN(0)) { OPAQUE_TID(); prep_phase(a, lds, vcu, G, wave, lane); }
    if (IN(0) && IN(1)) cg::this_grid().sync();
    GEMM_SWIGLU(1, WS_WUP1)
    SYNC_AFTER(1);
    GEMM_RESID(2, P_HB, WS_WDN1, DFF, a.in[0], 0.5f, P_XB, P_SSQ)
    SYNC_AFTER(2);
    if (IN(3)) {
        pg8::Gemm g{P_XB, (const bf16_t*)(ws + WS_WIN), MTOK, NIN, DM}; pg8::StaticOrder S; S.init(MTOK, NIN, G, bx);
        pg8::EpiProj E; unsigned char* A = ws + WS_A;
        E.P.QA = (bf16_t*)(A + A_QA); E.P.KC = (bf16_t*)(A + A_KC); E.P.VC = (bf16_t*)(A + A_VC); E.P.KS = (bf16_t*)(A + A_KS); E.P.VS = (bf16_t*)(A + A_VS); E.P.KW = (bf16_t*)(A + A_KW); E.P.VW = (bf16_t*)(A + A_VW);
        E.P.QB = (bf16_t*)(A + A_QB); E.P.KB = (bf16_t*)(A + A_KB); E.P.VB = (bf16_t*)(A + A_VB); E.P.GM = P_GM; E.P.GA = (float*)(ws + WS_GA); E.P.LF = (float*)(ws + WS_LF);
        E.ssq = P_SSQ; E.nsa_q_gain = a.in[7]; E.nsa_k_gain = a.in[8]; E.fox_q_gain = a.in[9]; E.fox_k_gain = a.in[10]; E.b_forget = a.in[6];
        pg8::gemm_phase<pg8::EpiProj, pg8::StaticOrder, true, true>(lds, g, S, E, MYTID());
    }
    SYNC_AFTER(3);
    if (IN(4)) { OPAQUE_TID();
        for (int U = vcu; U < 256; U += G) { int tu = tid; asm volatile("" : "+v"(tu)); compress_unit(U, a, lds, tu, wave, tu & 63); }
        for (int U = vcu; U < 1024; U += G) { const int i = U >> 8, v = U & 255, bh = v >> 1, half = v & 1; const int qb = (i == 0) ? half : (i == 1) ? 7 - half : (i == 2) ? 2 + half : 5 - half;
            int tu = tid; asm volatile("" : "+v"(tu)); fox_unit(bh >> 3, bh & 7, qb, a, lds, tu, wave, tu & 63); }
    }
    SYNC_AFTER(4);
    if (IN(5)) { OPAQUE_TID();
        { const float* TAB = (const float*)(ws + WS_TAB); LAS float* tl = (LAS float*)(lds + NL_TAB); for (int i = tid; i < 1024; i += NTHREADS) tl[i] = TAB[i]; }
        __syncthreads();
        for (int U = vcu; U < 1024; U += G) { const int i = U >> 8, v = U & 255, bg = v >> 3, s = v & 7; const int tq = (i == 0) ? s : (i == 1) ? 15 - s : (i == 2) ? 16 + s : 31 - s;
            int tu = tid; asm volatile("" : "+v"(tu)); nsa_unit(bg >> 1, bg & 1, tq, a, lds, tu, wave, tu & 63); }
    }
    SYNC_AFTER(5);
    GEMM_GATE(6, P_XB, WS_WON, 0, true)
    GEMM_GATE(7, P_XB + (size_t)MTOK * 512, WS_WOF, 1024, false)
    SYNC_AFTER(7);
    GEMM_RESID(8, P_MERGED, WS_WOUT, DM, a.out, 1.0f, P_XB, P_SSQ)
    SYNC_AFTER(8);
    GEMM_SWIGLU(9, WS_WUP2)
    SYNC_AFTER(9);
    GEMM_RESID(10, P_HB, WS_WDN2, DFF, a.out, 0.5f, (bf16_t*)nullptr, (float*)nullptr)
}

extern "C" void kernel_launch(void* const* d_in, const int* in_sizes, int n_in, void* d_out, int out_size, void* d_ws, size_t ws_size, hipStream_t stream) {
    static int grid = 0;
    if (grid == 0) {
        if (n_in != 24 || in_sizes[0] != MTOK * DM || out_size != MTOK * DM || ws_size < WS_END) { fprintf(stderr, "kernel_launch: unexpected shapes (n_in %d, in0 %d, out %d, ws %zu < %zu)\n", n_in, n_in > 0 ? in_sizes[0] : -1, out_size, ws_size, (size_t)WS_END); grid = -1; return; }
        int dev = 0, cus = 0, per_cu = 0;
        if (hipGetDevice(&dev) != hipSuccess || hipDeviceGetAttribute(&cus, hipDeviceAttributeMultiprocessorCount, dev) != hipSuccess) { grid = -1; return; }
        if (hipFuncSetAttribute((const void*)fwd_kernel, hipFuncAttributeMaxDynamicSharedMemorySize, LDS_BYTES) != hipSuccess) { fprintf(stderr, "kernel_launch: hipFuncSetAttribute failed\n"); grid = -1; return; }
        if (hipOccupancyMaxActiveBlocksPerMultiprocessor(&per_cu, (const void*)fwd_kernel, NTHREADS, LDS_BYTES) != hipSuccess || per_cu < 1) { fprintf(stderr, "kernel_launch: occupancy query reports %d blocks per CU\n", per_cu); (void)hipGetLastError(); grid = -1; return; }
        grid = cus;
    }
    if (grid < 0) return;
    if (hipMemsetAsync(d_ws, 0, 65536, stream) != hipSuccess) { fprintf(stderr, "kernel_launch: memset of the control words failed\n"); return; }
    Args a{};
    for (int i = 0; i < 24; ++i) a.in[i] = (const float*)d_in[i];
    a.out = (float*)d_out; a.ws = (unsigned char*)d_ws;
#if MK_MULTI_LAUNCH
    for (int ph = 0; ph < NPHASE; ++ph) { a.ph_lo = ph; a.ph_hi = ph + 1; hipLaunchKernelGGL(fwd_kernel, dim3(grid), dim3(NTHREADS), LDS_BYTES, stream, a); }
#else
    a.ph_lo = 0; a.ph_hi = NPHASE;
    void* args[] = {&a};
    const hipError_t e = hipLaunchCooperativeKernel((const void*)fwd_kernel, dim3(grid), dim3(NTHREADS), args, LDS_BYTES, stream);
    if (e != hipSuccess) fprintf(stderr, "kernel_launch: cooperative launch failed: %s (grid %d)\n", hipGetErrorString(e), grid);
#endif
}
```

```cpp
#include <hip/hip_runtime.h>
#include <hip/hip_cooperative_groups.h>
#include <cstdio>
#include <cstdint>
namespace cg = cooperative_groups;

namespace pg8 {
#define PG8_LAS __attribute__((address_space(3)))
typedef unsigned short bf16_t;
typedef short bf16x8 __attribute__((ext_vector_type(8)));
typedef float f32x4 __attribute__((ext_vector_type(4)));
typedef unsigned u32x4 __attribute__((ext_vector_type(4)));
constexpr int BM = 256, BK = 64, HALF = 128, HTB = HALF * BK * 2  , STAGE_BYTES = 8 * HTB, NXCD = 8, WGM = 8;

__host__ __device__ __forceinline__ int lds_byte(int r, int c) { const int st = (r >> 4) * 2 + (c >> 5), rr = r & 15, cc = c & 31, ob = rr * 64 + cc * 2; return st * 1024 + (ob ^ (((ob >> 9) & 1) << 5)); }
__host__ __device__ __forceinline__ void stage_rc(int b, int& R, int& C) { const int st = b / 1024, sb = b % 1024, swz = sb ^ (((sb >> 9) & 1) << 5); R = (st >> 1) * 16 + swz / 64; C = (st & 1) * 32 + (swz % 64) / 2; }
__host__ __device__ __forceinline__ int perm32(int rho) { const int n = rho >> 4, i = rho & 15; return 8 * (i >> 2) + 4 * n + (i & 3); }

struct Unit { int pm, pn; };
struct Gemm { const bf16_t* A; const bf16_t* Bt; int M, N, K; };

struct StaticOrder {
    int nM, nN, nwg, G, c;
    __host__ __device__ void init(int M, int N, int G_, int c_) { nM = M / BM; nN = N / BM; nwg = nM * nN; G = G_; c = c_; }
    __host__ __device__ bool next(int i, Unit& u) const {
        const long L = (long)i * G + c; if (L >= nwg) return false;
        int wgid = (int)L; { const int q = nwg / NXCD, r = nwg % NXCD, xcd = wgid % NXCD, off = wgid / NXCD; wgid = (xcd < r ? xcd * (q + 1) : r * (q + 1) + (xcd - r) * q) + off; }
        const int nig = WGM * nN, gid = wgid / nig, fm = gid * WGM, gsz = (nM - fm) < WGM ? (nM - fm) : WGM;
        u.pm = fm + ((wgid % nig) % gsz); u.pn = (wgid % nig) / gsz; return true;
    }
    __device__ __forceinline__ void a_ready(const Unit&) const {}
    __device__ __forceinline__ void done(const Unit&) const {}
};

typedef float f32x2 __attribute__((ext_vector_type(2)));
typedef __bf16 bf16x2_t __attribute__((ext_vector_type(2)));
typedef unsigned u32x2 __attribute__((ext_vector_type(2)));
__device__ __forceinline__ unsigned cvt_pk_bf16(float lo, float hi) { f32x2 v = {lo, hi}; bf16x2_t b = __builtin_convertvector(v, bf16x2_t); return __builtin_bit_cast(unsigned, b); }
__device__ __forceinline__ float bf_lo(unsigned w) { return __uint_as_float(w << 16); }
__device__ __forceinline__ float bf_hi(unsigned w) { return __uint_as_float(w & 0xffff0000u); }
constexpr float LOG2E = 1.4426950408889634f;
__device__ __forceinline__ float fast_sigmoid(float x) { return __builtin_amdgcn_rcpf(1.0f + __builtin_amdgcn_exp2f(-x * LOG2E)); }
__device__ __forceinline__ float silu_f(float x) { return x * fast_sigmoid(x); }
constexpr float RMS_EPS = 1e-6f;
__device__ __forceinline__ float row_rinv(const float* ssq, int row, int fq) {
    const f32x4 p = *(const f32x4*)(ssq + (size_t)row * 16 + 4 * fq);
    float s = (p[0] + p[1]) + (p[2] + p[3]);
    s += __shfl_xor(s, 16); s += __shfl_xor(s, 32);
    return __builtin_amdgcn_rsqf(s * (1.0f / 1024.0f) + RMS_EPS);
}

__device__ __forceinline__ void row_rinv8(float (&rs)[8], const float* ssq, int row0, int fq) {
    f32x4 pr[8];
#pragma unroll
    for (int q = 0; q < 8; ++q) pr[q] = *(const f32x4*)(ssq + (size_t)(row0 + (q >> 2) * HALF + (q & 3) * 16) * 16 + 4 * fq);
#pragma unroll
    for (int q = 0; q < 8; ++q) { float s = (pr[q][0] + pr[q][1]) + (pr[q][2] + pr[q][3]); s += __shfl_xor(s, 16); s += __shfl_xor(s, 32); rs[q] = __builtin_amdgcn_rsqf(s * (1.0f / 1024.0f) + RMS_EPS); }
}
struct EpiSwiGLU {
    static constexpr bool PERM = true, AFTER_DRAIN = false;
    bf16_t* H; int ldh; const float* ssq;
    __device__ __forceinline__ void operator()(const f32x4 (&acc)[2][2][4][2], const Unit& u, int wr, int wc, int fr, int fq) const {
        const int row0 = u.pm * BM + wr * 64 + fr, col0 = u.pn * HALF + wc * 32 + 8 * fq;
        float rsv[8]; row_rinv8(rsv, ssq, row0, fq);
#pragma unroll
        for (int ai = 0; ai < 2; ++ai)
#pragma unroll
            for (int m = 0; m < 4; ++m) { const int row = row0 + ai * HALF + m * 16; const float rs = rsv[ai * 4 + m];
                float o[8];
#pragma unroll
                for (int n = 0; n < 2; ++n)
#pragma unroll
                    for (int i = 0; i < 4; ++i) { const float g = acc[ai][0][m][n][i] * rs, up = acc[ai][1][m][n][i] * rs; o[4 * n + i] = silu_f(g) * up; }
                u32x4 w; w.x = cvt_pk_bf16(o[0], o[1]); w.y = cvt_pk_bf16(o[2], o[3]); w.z = cvt_pk_bf16(o[4], o[5]); w.w = cvt_pk_bf16(o[6], o[7]);
                *(u32x4*)(H + (size_t)row * ldh + col0) = w; }
    }
};

struct EpiResid {
    static constexpr bool PERM = true, AFTER_DRAIN = false;
    const float* bf; const bf16_t* bb; float* of; bf16_t* ob; float alpha; float* ssq;
    __device__ __forceinline__ void operator()(const f32x4 (&acc)[2][2][4][2], const Unit& u, int wr, int wc, int fr, int fq) const {
        const int row0 = u.pm * BM + wr * 64 + fr, col0 = u.pn * BM + wc * 32 + 8 * fq;
#pragma unroll
        for (int ai = 0; ai < 2; ++ai) {
            f32x4 bs[4][2][2];
            if (bf) {
#pragma unroll
                for (int m = 0; m < 4; ++m) { const size_t off = (size_t)(row0 + ai * HALF + m * 16) * 1024 + col0;
#pragma unroll
                    for (int bj = 0; bj < 2; ++bj)
#pragma unroll
                        for (int n = 0; n < 2; ++n) bs[m][bj][n] = *(const f32x4*)(bf + off + bj * HALF + n * 4); }
            } else {
                u32x4 bw[4][2];
#pragma unroll
                for (int m = 0; m < 4; ++m) { const size_t off = (size_t)(row0 + ai * HALF + m * 16) * 1024 + col0;
#pragma unroll
                    for (int bj = 0; bj < 2; ++bj) bw[m][bj] = *(const u32x4*)(bb + off + bj * HALF); }
#pragma unroll
                for (int m = 0; m < 4; ++m)
#pragma unroll
                    for (int bj = 0; bj < 2; ++bj) { bs[m][bj][0] = (f32x4){bf_lo(bw[m][bj][0]), bf_hi(bw[m][bj][0]), bf_lo(bw[m][bj][1]), bf_hi(bw[m][bj][1])};
                        bs[m][bj][1] = (f32x4){bf_lo(bw[m][bj][2]), bf_hi(bw[m][bj][2]), bf_lo(bw[m][bj][3]), bf_hi(bw[m][bj][3])}; }
            }
            asm volatile("" ::: "memory");
#pragma unroll
            for (int m = 0; m < 4; ++m) { const int row = row0 + ai * HALF + m * 16; const size_t off = (size_t)row * 1024 + col0; float ss = 0.f;
#pragma unroll
                for (int bj = 0; bj < 2; ++bj) { const f32x4 v0 = bs[m][bj][0] + acc[ai][bj][m][0] * alpha, v1 = bs[m][bj][1] + acc[ai][bj][m][1] * alpha;
                    ss += ((v0[0] * v0[0] + v0[1] * v0[1]) + (v0[2] * v0[2] + v0[3] * v0[3])) + ((v1[0] * v1[0] + v1[1] * v1[1]) + (v1[2] * v1[2] + v1[3] * v1[3]));
                    if (of) { *(f32x4*)(of + off + bj * HALF) = v0; *(f32x4*)(of + off + bj * HALF + 4) = v1; }
                    if (ob) { u32x4 w; w.x = cvt_pk_bf16(v0[0], v0[1]); w.y = cvt_pk_bf16(v0[2], v0[3]); w.z = cvt_pk_bf16(v1[0], v1[1]); w.w = cvt_pk_bf16(v1[2], v1[3]); *(u32x4*)(ob + off + bj * HALF) = w; } }
                if (ssq) { ss += __shfl_xor(ss, 16); ss += __shfl_xor(ss, 32); if (fq == 0) ssq[(size_t)row * 16 + 4 * u.pn + wc] = ss; } }
            asm volatile("" ::: "memory");
        }
    }
};

struct EpiGate {
    static constexpr bool PERM = true, AFTER_DRAIN = false;
    bf16_t* T; const bf16_t* gate; int goff; bool first;
    __device__ __forceinline__ void operator()(const f32x4 (&acc)[2][2][4][2], const Unit& u, int wr, int wc, int fr, int fq) const {
        const int row0 = u.pm * BM + wr * 64 + fr, col0 = u.pn * BM + wc * 32 + 8 * fq;
#pragma unroll
        for (int ai = 0; ai < 2; ++ai) {
            u32x4 gw[4][2], tw[4][2];
#pragma unroll
            for (int m = 0; m < 4; ++m)
#pragma unroll
                for (int bj = 0; bj < 2; ++bj) { const int row = row0 + ai * HALF + m * 16, c = col0 + bj * HALF;
                    gw[m][bj] = *(const u32x4*)(gate + (size_t)row * 2048 + goff + c);
                    tw[m][bj] = first ? (u32x4){0u, 0u, 0u, 0u} : *(const u32x4*)(T + (size_t)row * 1024 + c); }
            asm volatile("" ::: "memory");
#pragma unroll
            for (int m = 0; m < 4; ++m)
#pragma unroll
                for (int bj = 0; bj < 2; ++bj) { const int row = row0 + ai * HALF + m * 16, c = col0 + bj * HALF;
                    float o[8];
#pragma unroll
                    for (int q = 0; q < 4; ++q) { o[2 * q] = bf_lo(gw[m][bj][q]) * acc[ai][bj][m][q >> 1][(2 * q) & 3] + bf_lo(tw[m][bj][q]); o[2 * q + 1] = bf_hi(gw[m][bj][q]) * acc[ai][bj][m][q >> 1][(2 * q + 1) & 3] + bf_hi(tw[m][bj][q]); }
                    u32x4 w; w.x = cvt_pk_bf16(o[0], o[1]); w.y = cvt_pk_bf16(o[2], o[3]); w.z = cvt_pk_bf16(o[4], o[5]); w.w = cvt_pk_bf16(o[6], o[7]);
                    *(u32x4*)(T + (size_t)row * 1024 + c) = w; }
            asm volatile("" ::: "memory");
        }
    }
};

struct ProjOut { bf16_t *QA, *KC, *VC, *KS, *VS, *KW, *VW, *QB, *KB, *VB, *GM; float *GA, *LF; };
constexpr float QSCALE = 0.125f * LOG2E;
struct EpiProj {
    static constexpr bool PERM = true, AFTER_DRAIN = false;
    ProjOut P; const float* ssq; const float *nsa_q_gain, *nsa_k_gain, *fox_q_gain, *fox_k_gain, *b_forget;
    __device__ __forceinline__ void operator()(const f32x4 (&acc)[2][2][4][2], const Unit& u, int wr, int wc, int fr, int fq) const {
        const int row0 = u.pm * BM + wr * 64 + fr; const int pn = u.pn;
        if (pn == 19) {
            if (wc != 0) return;
            f32x4 bfv[2]; bfv[0] = *(const f32x4*)(b_forget); bfv[1] = *(const f32x4*)(b_forget + 4);
            float rsv[8]; row_rinv8(rsv, ssq, row0, fq);
#pragma unroll
            for (int ai = 0; ai < 2; ++ai)
#pragma unroll
                for (int m = 0; m < 4; ++m) { const int row = row0 + ai * HALF + m * 16; const float rs = rsv[ai * 4 + m];
#pragma unroll
                    for (int n = 0; n < 2; ++n) { const f32x4 v = acc[ai][0][m][n] * rs; f32x4 o;
                        if (fq < 3) {
#pragma unroll
                            for (int i = 0; i < 4; ++i) o[i] = 1.0f / (1.0f + __expf(-v[i]));
                            *(f32x4*)(P.GA + (size_t)row * 24 + 8 * fq + 4 * n) = o;
                        } else {
#pragma unroll
                            for (int i = 0; i < 4; ++i) { const float x = v[i] + bfv[n][i]; o[i] = fminf(x, 0.f) - log1pf(__expf(-fabsf(x))); }
                            *(f32x4*)(P.LF + (size_t)row * 8 + 4 * n) = o;
                        } } }
            return;
        }
        int kind = 0; const float* gain = nullptr; float mul = 1.f; bf16_t* dst = nullptr; int pitch = 128;
        if (pn < 2) { kind = 1; gain = nsa_q_gain; mul = QSCALE; dst = P.QA + 256 * pn + 64 * wc; pitch = 512; }
        else if (pn == 2) { dst = (wc < 2) ? P.KC + 64 * wc : P.VC + 64 * (wc - 2); }
        else if (pn == 3) { if (wc < 2) { kind = 1; gain = nsa_k_gain + 64; dst = P.KS + 64 * wc; } else dst = P.VS + 64 * (wc - 2); }
        else if (pn == 4) { if (wc < 2) { kind = 1; gain = nsa_k_gain + 128; dst = P.KW + 64 * wc; } else dst = P.VW + 64 * (wc - 2); }
        else if (pn < 7) { kind = 1; gain = fox_q_gain; mul = QSCALE; dst = P.QB + 256 * (pn - 5) + 64 * wc; pitch = 512; }
        else if (pn < 9) { kind = 1; gain = fox_k_gain; dst = P.KB + 256 * (pn - 7) + 64 * wc; pitch = 512; }
        else if (pn < 11) { dst = P.VB + 256 * (pn - 9) + 64 * wc; pitch = 512; }
        else { kind = 2; dst = P.GM + 256 * (pn - 11) + 64 * wc; pitch = 2048; }
        f32x4 gv[2][2];
#pragma unroll
        for (int bj = 0; bj < 2; ++bj)
#pragma unroll
            for (int n = 0; n < 2; ++n) { gv[bj][n] = (f32x4){1.f, 1.f, 1.f, 1.f}; if (kind == 1) gv[bj][n] = *(const f32x4*)(gain + 32 * bj + 8 * fq + 4 * n); }
        float rsv[8]; row_rinv8(rsv, ssq, row0, fq);
#pragma unroll
        for (int ai = 0; ai < 2; ++ai)
#pragma unroll
            for (int m = 0; m < 4; ++m) { const int row = row0 + ai * HALF + m * 16; const float rs = rsv[ai * 4 + m];
                float hs = rs;
                if (kind == 1) { float ss = 0.f;
#pragma unroll
                    for (int bj = 0; bj < 2; ++bj)
#pragma unroll
                        for (int n = 0; n < 2; ++n) { const f32x4 v = acc[ai][bj][m][n] * rs; ss += (v[0] * v[0] + v[1] * v[1]) + (v[2] * v[2] + v[3] * v[3]); }
                    ss += __shfl_xor(ss, 16); ss += __shfl_xor(ss, 32); hs = rs * __builtin_amdgcn_rsqf(ss * (1.0f / 64.0f) + RMS_EPS) * mul; }
#pragma unroll
                for (int bj = 0; bj < 2; ++bj) { float o[8];
#pragma unroll
                    for (int n = 0; n < 2; ++n) { const f32x4 gvn = gv[bj][n];
#pragma unroll
                        for (int i = 0; i < 4; ++i) { float x = acc[ai][bj][m][n][i] * hs; if (kind == 2) x = fast_sigmoid(x); else x = x * gvn[i]; o[4 * n + i] = x; } }
                    u32x4 w; w.x = cvt_pk_bf16(o[0], o[1]); w.y = cvt_pk_bf16(o[2], o[3]); w.z = cvt_pk_bf16(o[4], o[5]); w.w = cvt_pk_bf16(o[6], o[7]);
                    *(u32x4*)(dst + (size_t)row * pitch + 32 * bj + 8 * fq) = w; } }
    }
};

template <class Epi, class Sched, bool ALIGN_EPI = false, bool SP2 = false>
__device__ __forceinline__ void gemm_phase(PG8_LAS unsigned char* lds, const Gemm g, const Sched& S, const Epi& E, int tid_in) {
    int tid_ = tid_in; asm volatile("" : "+v"(tid_));
    const int tid = tid_, wid = __builtin_amdgcn_readfirstlane(tid >> 6), lane = tid & 63, wr = wid >> 2, wc = wid & 3, fr = lane & 15, fq = lane >> 4;
    const int K = g.K, nt = K / BK;
    unsigned voffA[2], voffB[2];
#pragma unroll
    for (int i = 0; i < 2; ++i) { int R, C; stage_rc(tid * 16 + i * 8192, R, C); const int Rb = Epi::PERM ? ((R & ~31) + perm32(R & 31)) : R;
        voffA[i] = (unsigned)(R * K + C) * 2u; voffB[i] = (unsigned)(Rb * K + C) * 2u; }
    const size_t kstep = (size_t)(BK * 2);
    const size_t hstep = (size_t)HALF * K * 2;
    const size_t tstep = 2 * hstep;
    const unsigned ldsw = (unsigned)wid * 1024u;
    const int aoff = lds_byte(wr * 64 + fr, fq * 8), boff = lds_byte(wc * 32 + fr, fq * 8);
#define PG8_SA(b, h) (((b) * 2 + (h)) * HTB)
#define PG8_SB(b, h) ((4 + (b) * 2 + (h)) * HTB)
#define PG8_STAGE(bufoff, gbase, voff) do { _Pragma("unroll") for (int _i = 0; _i < 2; ++_i) \
        __builtin_amdgcn_global_load_lds((const unsigned*)((const char*)(gbase) + (voff)[_i]), (PG8_LAS unsigned*)(lds + (bufoff) + ldsw + _i * 8192), 16, 0, 0); } while (0)
#define PG8_LDA(dst, b, h) do { _Pragma("unroll") for (int m = 0; m < 4; ++m) _Pragma("unroll") for (int k = 0; k < 2; ++k) dst[m][k] = *(const PG8_LAS bf16x8*)(lds + PG8_SA(b, h) + aoff + m * 2048 + k * 1024); } while (0)
#define PG8_LDB(dst, b, h) do { _Pragma("unroll") for (int n = 0; n < 2; ++n) _Pragma("unroll") for (int k = 0; k < 2; ++k) dst[n][k] = *(const PG8_LAS bf16x8*)(lds + PG8_SB(b, h) + boff + n * 2048 + k * 1024); } while (0)
#define PG8_MMA(ai, bj, At, Bt) do { __builtin_amdgcn_s_setprio(1); _Pragma("unroll") for (int m = 0; m < 4; ++m) _Pragma("unroll") for (int n = 0; n < 2; ++n) _Pragma("unroll") for (int k = 0; k < 2; ++k) \
        acc[ai][bj][m][n] = __builtin_amdgcn_mfma_f32_16x16x32_bf16(Bt[n][k], At[m][k], acc[ai][bj][m][n], 0, 0, 0); __builtin_amdgcn_s_setprio(0); } while (0)
#define PG8_WAIT_V(n) asm volatile("s_waitcnt vmcnt(" #n ")" ::: "memory")
#define PG8_WAIT_L(n) asm volatile("s_waitcnt lgkmcnt(" #n ")" ::: "memory")
#define PG8_BAR __builtin_amdgcn_s_barrier()
#define PG8_SCHED __builtin_amdgcn_sched_barrier(0)
    Unit cur, nxt; int ui = 0;
    if (!S.next(0, cur)) return;
    f32x4 acc[2][2][4][2];
#pragma unroll
    for (int a = 0; a < 2; ++a)
#pragma unroll
        for (int b = 0; b < 2; ++b)
#pragma unroll
            for (int m = 0; m < 4; ++m)
#pragma unroll
                for (int n = 0; n < 2; ++n) acc[a][b][m][n] = (f32x4){0.f, 0.f, 0.f, 0.f};
    bf16x8 At[4][2], B0[2][2], B1[2][2];
    const char* cA = (const char*)g.A + (size_t)cur.pm * tstep; const char* cB = (const char*)g.Bt + (size_t)cur.pn * tstep;
    S.a_ready(cur);
    if constexpr (SP2) {
        PG8_STAGE(PG8_SB(0, 0), cB, voffB); PG8_STAGE(PG8_SB(0, 1), cB + hstep, voffB); PG8_STAGE(PG8_SA(0, 0), cA, voffA); PG8_STAGE(PG8_SA(0, 1), cA + hstep, voffA);
        if (wr == 1) PG8_BAR;
        PG8_WAIT_V(2); PG8_BAR;
        PG8_STAGE(PG8_SB(1, 0), cB + kstep, voffB); PG8_STAGE(PG8_SA(1, 0), cA + kstep, voffA); PG8_STAGE(PG8_SB(1, 1), cB + hstep + kstep, voffB);
        PG8_WAIT_V(6); PG8_BAR;
    } else {
        PG8_STAGE(PG8_SB(0, 0), cB, voffB); PG8_STAGE(PG8_SA(0, 0), cA, voffA); PG8_STAGE(PG8_SB(0, 1), cB + hstep, voffB); PG8_STAGE(PG8_SA(0, 1), cA + hstep, voffA);
        if (wr == 1) PG8_BAR;
        PG8_WAIT_V(4); PG8_BAR;
        PG8_STAGE(PG8_SB(1, 0), cB + kstep, voffB); PG8_STAGE(PG8_SA(1, 0), cA + kstep, voffA); PG8_STAGE(PG8_SB(1, 1), cB + hstep + kstep, voffB);
        PG8_WAIT_V(6); PG8_BAR;
    }
    for (;;) {
        const bool has_next = S.next(ui + 1, nxt);
        const char* nA = has_next ? (const char*)g.A + (size_t)nxt.pm * tstep : cA; const char* nB = has_next ? (const char*)g.Bt + (size_t)nxt.pn * tstep : cB;
        for (int t = 0; t < nt; t += 2) {
            const bool last = (t == nt - 2);
            const char* a1 = cA + (size_t)(t + 1) * kstep;
            const char* a2 = last ? nA : cA + (size_t)(t + 2) * kstep; const char* b2 = last ? nB : cB + (size_t)(t + 2) * kstep;
            const char* a3 = a2 + kstep; const char* b3 = b2 + kstep;
            if (last && has_next) S.a_ready(nxt);
            if constexpr (SP2) {
            PG8_LDB(B0, 0, 0); PG8_LDB(B1, 0, 1); PG8_SCHED; PG8_LDA(At, 0, 0); PG8_STAGE(PG8_SA(1, 1), a1 + hstep, voffA);
            PG8_WAIT_V(8); PG8_WAIT_L(0); PG8_BAR; PG8_MMA(0, 0, At, B0); PG8_MMA(0, 1, At, B1); PG8_BAR; PG8_SCHED;
            PG8_LDA(At, 0, 1); PG8_STAGE(PG8_SB(0, 0), b2, voffB); PG8_STAGE(PG8_SB(0, 1), b2 + hstep, voffB); PG8_STAGE(PG8_SA(0, 0), a2, voffA);
            PG8_WAIT_V(8); PG8_WAIT_L(0); PG8_BAR; PG8_MMA(1, 0, At, B0); PG8_MMA(1, 1, At, B1); PG8_BAR; PG8_SCHED;
            PG8_LDB(B0, 1, 0); PG8_LDB(B1, 1, 1); PG8_SCHED; PG8_LDA(At, 1, 0); PG8_STAGE(PG8_SA(0, 1), a2 + hstep, voffA);
            PG8_WAIT_V(8); PG8_WAIT_L(0); PG8_BAR; PG8_MMA(0, 0, At, B0); PG8_MMA(0, 1, At, B1); PG8_BAR; PG8_SCHED;
            PG8_LDA(At, 1, 1); PG8_STAGE(PG8_SB(1, 0), b3, voffB); PG8_STAGE(PG8_SB(1, 1), b3 + hstep, voffB); PG8_STAGE(PG8_SA(1, 0), a3, voffA);
            PG8_WAIT_V(8); PG8_WAIT_L(0); PG8_BAR; PG8_MMA(1, 0, At, B0); PG8_MMA(1, 1, At, B1); PG8_BAR; PG8_SCHED;
            } else {
            PG8_LDB(B0, 0, 0); PG8_SCHED; PG8_LDA(At, 0, 0); PG8_STAGE(PG8_SA(1, 1), a1 + hstep, voffA);
            PG8_WAIT_L(8); PG8_BAR; PG8_WAIT_L(0); PG8_MMA(0, 0, At, B0); PG8_BAR; PG8_SCHED;
            PG8_LDB(B1, 0, 1); PG8_STAGE(PG8_SB(0, 0), b2, voffB);
            PG8_BAR; PG8_WAIT_L(0); PG8_MMA(0, 1, At, B1); PG8_BAR;
            PG8_LDA(At, 0, 1); PG8_STAGE(PG8_SA(0, 0), a2, voffA);
            PG8_BAR; PG8_WAIT_L(0); PG8_MMA(1, 0, At, B0); PG8_BAR; PG8_SCHED;
            PG8_STAGE(PG8_SB(0, 1), b2 + hstep, voffB);
            PG8_WAIT_V(6); PG8_BAR; PG8_MMA(1, 1, At, B1); PG8_BAR;
            PG8_LDB(B0, 1, 0); PG8_SCHED; PG8_LDA(At, 1, 0); PG8_STAGE(PG8_SA(0, 1), a2 + hstep, voffA);
            PG8_WAIT_L(8); PG8_BAR; PG8_WAIT_L(0); PG8_MMA(0, 0, At, B0); PG8_BAR; PG8_SCHED;
            PG8_LDB(B1, 1, 1); PG8_STAGE(PG8_SB(1, 0), b3, voffB);
            PG8_BAR; PG8_WAIT_L(0); PG8_MMA(0, 1, At, B1); PG8_BAR;
            PG8_LDA(At, 1, 1); PG8_STAGE(PG8_SA(1, 0), a3, voffA);
            PG8_BAR; PG8_WAIT_L(0); PG8_MMA(1, 0, At, B0); PG8_BAR; PG8_SCHED;
            PG8_STAGE(PG8_SB(1, 1), b3 + hstep, voffB);
            PG8_WAIT_V(6); PG8_BAR; PG8_MMA(1, 1, At, B1); PG8_BAR;
            }
        }
        if constexpr (ALIGN_EPI) { if (wr == 0) PG8_BAR; }
        if constexpr (!Epi::AFTER_DRAIN) { E(acc, cur, wr, wc, fr, fq); S.done(cur); }
        if (!has_next) break;
#pragma unroll
        for (int a = 0; a < 2; ++a)
#pragma unroll
            for (int b = 0; b < 2; ++b)
#pragma unroll
                for (int m = 0; m < 4; ++m)
#pragma unroll
                    for (int n = 0; n < 2; ++n) acc[a][b][m][n] = (f32x4){0.f, 0.f, 0.f, 0.f};
        cur = nxt; cA = nA; cB = nB; ++ui;
        if constexpr (ALIGN_EPI) { if (wr == 1) PG8_BAR; }
    }
    PG8_WAIT_V(0);
    if constexpr (!ALIGN_EPI) { if (wr == 0) PG8_BAR; }
    PG8_BAR;
    if constexpr (Epi::AFTER_DRAIN) { E.fused(acc, cur, wr, wc, fr, fq, lds, wid, lane); S.done(cur); }
#undef PG8_SA
#undef PG8_SB
#undef PG8_STAGE
#undef PG8_LDA
#undef PG8_LDB
#undef PG8_MMA
#undef PG8_WAIT_V
#undef PG8_WAIT_L
#undef PG8_BAR
#undef PG8_SCHED
}
}

constexpr int BATCH = 16, SEQ = 2048, DM = 1024, MTOK = BATCH * SEQ, DFF = 2816, NUP = 2 * DFF, D_IN = 4896, NIN = 5120;
constexpr int NWAVES = 8, NTHREADS = 512;
#define LAS __attribute__((address_space(3)))
typedef pg8::bf16_t bf16_t;
typedef short bf16x8 __attribute__((ext_vector_type(8)));
typedef float f32x4 __attribute__((ext_vector_type(4)));
typedef float f32x16 __attribute__((ext_vector_type(16)));
typedef unsigned u32x4 __attribute__((ext_vector_type(4)));
typedef unsigned u32x2 __attribute__((ext_vector_type(2)));
typedef short s16x4 __attribute__((ext_vector_type(4)));
using pg8::cvt_pk_bf16; using pg8::LOG2E; using pg8::RMS_EPS;

constexpr size_t MiB = 1u << 20, KiB = 1u << 10;
constexpr size_t WS_WUP1 = 1 * MiB, WS_WDN1 = 12 * MiB, WS_WIN = 18 * MiB, WS_WON = 28 * MiB, WS_WOF = 29 * MiB, WS_WOUT = 30 * MiB, WS_WUP2 = 32 * MiB, WS_WDN2 = 43 * MiB;
constexpr size_t WS_CW1K = 49 * MiB, WS_CW1V = 49 * MiB + 512 * KiB, WS_CW2K = 50 * MiB, WS_CW2V = 50 * MiB + 64 * KiB, WS_TAB = 50 * MiB + 128 * KiB, WS_C1 = 50 * MiB + 192 * KiB;
constexpr size_t WS_KCMP = 51 * MiB, WS_VCMP = 51 * MiB + 512 * KiB, WS_SSQ = 52 * MiB, WS_GA = 54 * MiB, WS_LF = 57 * MiB;
constexpr size_t WS_XB = 58 * MiB;
constexpr size_t WS_A = 122 * MiB;
constexpr size_t A_QA = 0, A_KC = 32 * MiB, A_VC = 40 * MiB, A_KS = 48 * MiB, A_VS = 56 * MiB, A_KW = 64 * MiB, A_VW = 72 * MiB, A_QB = 80 * MiB, A_KB = 112 * MiB, A_VB = 144 * MiB, A_GM = 176 * MiB;
constexpr size_t WS_END = 426 * MiB;
constexpr int LDS_BYTES = 147456;

__constant__ unsigned char T5_BUCKET[128] = {0, 1, 2, 3, 4, 5, 6, 7, 8, 9, 10, 11, 12, 13, 14, 15, 16, 16, 16, 17, 17, 18, 18, 18, 19, 19, 19, 20, 20, 20, 20, 21, 21, 21, 21, 22, 22, 22, 22, 22, 23, 23, 23, 23, 23, 23, 24, 24, 24, 24, 24, 24, 25, 25, 25, 25, 25, 25, 25, 26, 26, 26, 26, 26, 26, 26, 26, 27, 27, 27, 27, 27, 27, 27, 27, 27, 27, 28, 28, 28, 28, 28, 28, 28, 28, 28, 28, 29, 29, 29, 29, 29, 29, 29, 29, 29, 29, 29, 29, 30, 30, 30, 30, 30, 30, 30, 30, 30, 30, 30, 30, 30, 30, 31, 31, 31, 31, 31, 31, 31, 31, 31, 31, 31, 31, 31, 31, 31};

struct Args { const float* in[24]; float* out; unsigned char* ws; int ph_lo, ph_hi; };

#define LDS_WAIT() asm volatile("s_waitcnt lgkmcnt(0)" ::: "memory")
__device__ __forceinline__ float wave_sum(float v) {
#pragma unroll
    for (int o = 1; o < 64; o <<= 1) v += __shfl_xor(v, o);
    return v;
}

template <int MODE> __device__ __forceinline__ int src_col(int n) {
    if (MODE == 0) return n;
    if (MODE == 1) { const int pn = n >> 8, bj = (n >> 7) & 1, q = n & 127; return bj * DFF + 128 * pn + q; }
    const int pn = n >> 8, bj = (n >> 7) & 1, wc = (n >> 5) & 3, j = n & 31, L = 256 * pn + 64 * wc + 32 * bj + j;
    if (L < 1280) return L;
    if (L < 2816) return 1304 + (L - 1280);
    if (L < 4864) return 2848 + (L - 2816);
    if (L < 4888) return 1280 + (L - 4864);
    if (L < 4896) return 2840 + (L - 4888);
    return -1;
}
template <int MODE> __device__ __forceinline__ void transpose_item(const float* W, int ldw, int K, int N, const float* ks, bf16_t* WT, LAS float* scr, int item, int lane) {
    const int nblk = N / 32, kb = item / nblk, nb = item % nblk, k0 = 64 * kb, n0 = 32 * nb;
    const int sc = src_col<MODE>(n0 + (lane & 31));
#pragma unroll
    for (int i0 = 0; i0 < 32; i0 += 16) { float v[16];
#pragma unroll
        for (int i = 0; i < 16; ++i) { const int kk = 2 * (i0 + i) + (lane >> 5); v[i] = (sc >= 0) ? W[(size_t)(k0 + kk) * ldw + sc] : 0.f; }
#pragma unroll
        for (int i = 0; i < 16; ++i) { const int kk = 2 * (i0 + i) + (lane >> 5); float x = v[i]; if (ks) x *= ks[k0 + kk]; scr[kk * 33 + (lane & 31)] = x; } }
    LDS_WAIT(); asm volatile("" ::: "memory");
    const int c = lane & 7;
#pragma unroll
    for (int j = 0; j < 4; ++j) { const int n = (lane >> 3) + 8 * j; const LAS float* s = scr + (8 * c) * 33 + n;
        u32x4 o; o.x = cvt_pk_bf16(s[0 * 33], s[1 * 33]); o.y = cvt_pk_bf16(s[2 * 33], s[3 * 33]); o.z = cvt_pk_bf16(s[4 * 33], s[5 * 33]); o.w = cvt_pk_bf16(s[6 * 33], s[7 * 33]);
        *(u32x4*)(WT + (size_t)(n0 + n) * K + k0 + 8 * c) = o; }
    LDS_WAIT(); asm volatile("" ::: "memory");
}

__device__ __forceinline__ void prep_phase(const Args& a, LAS unsigned char* lds, int vcu, int G, int wave, int lane) {
    unsigned char* ws = a.ws;
    LAS float* scr = (LAS float*)(lds + wave * 16384);
    const int gw = vcu * NWAVES + wave, NGW = G * NWAVES;
    constexpr int I_UP = (DM / 64) * (NUP / 32), I_DN = (DFF / 64) * (DM / 32), I_IN = (DM / 64) * (NIN / 32), I_O = (512 / 64) * (DM / 32), I_OUT = (DM / 64) * (DM / 32), I_C1 = (2048 / 64) * (128 / 32), I_C2 = (128 / 64) * (64 / 32);
    constexpr int NITEMS = 2 * I_UP + 2 * I_DN + I_IN + 2 * I_O + I_OUT + 2 * I_C1 + 2 * I_C2;
    for (int it = gw; it < NITEMS; it += NGW) {
        int r = it;
        if (r < I_UP) { transpose_item<1>(a.in[2], NUP, DM, NUP, a.in[1], (bf16_t*)(ws + WS_WUP1), scr, r, lane); continue; } r -= I_UP;
        if (r < I_UP) { transpose_item<1>(a.in[21], NUP, DM, NUP, a.in[20], (bf16_t*)(ws + WS_WUP2), scr, r, lane); continue; } r -= I_UP;
        if (r < I_DN) { transpose_item<0>(a.in[3], DM, DFF, DM, nullptr, (bf16_t*)(ws + WS_WDN1), scr, r, lane); continue; } r -= I_DN;
        if (r < I_DN) { transpose_item<0>(a.in[22], DM, DFF, DM, nullptr, (bf16_t*)(ws + WS_WDN2), scr, r, lane); continue; } r -= I_DN;
        if (r < I_IN) { transpose_item<2>(a.in[5], D_IN, DM, NIN, a.in[4], (bf16_t*)(ws + WS_WIN), scr, r, lane); continue; } r -= I_IN;
        if (r < I_O) { transpose_item<0>(a.in[17], DM, 512, DM, nullptr, (bf16_t*)(ws + WS_WON), scr, r, lane); continue; } r -= I_O;
        if (r < I_O) { transpose_item<0>(a.in[18], DM, 512, DM, nullptr, (bf16_t*)(ws + WS_WOF), scr, r, lane); continue; } r -= I_O;
        if (r < I_OUT) { transpose_item<0>(a.in[19], DM, DM, DM, nullptr, (bf16_t*)(ws + WS_WOUT), scr, r, lane); continue; } r -= I_OUT;
        if (r < I_C1) { transpose_item<0>(a.in[13], 128, 2048, 128, nullptr, (bf16_t*)(ws + WS_CW1K), scr, r, lane); continue; } r -= I_C1;
        if (r < I_C1) { transpose_item<0>(a.in[15], 128, 2048, 128, nullptr, (bf16_t*)(ws + WS_CW1V), scr, r, lane); continue; } r -= I_C1;
        if (r < I_C2) { transpose_item<0>(a.in[14], 64, 128, 64, nullptr, (bf16_t*)(ws + WS_CW2K), scr, r, lane); continue; } r -= I_C2;
        transpose_item<0>(a.in[16], 64, 128, 64, nullptr, (bf16_t*)(ws + WS_CW2V), scr, r, lane);
    }
    const float* x = a.in[0]; bf16_t* XB = (bf16_t*)(ws + WS_XB); float* SSQ = (float*)(ws + WS_SSQ);
    for (int m = gw; m < MTOK; m += 2 * NGW) {
        const int m2 = m + NGW;
        const f32x4* xr = (const f32x4*)(x + (size_t)m * DM) + lane; const f32x4* xr2 = (const f32x4*)(x + (size_t)(m2 < MTOK ? m2 : m) * DM) + lane; f32x4 v[4], w2[4]; float s = 0.f, s2 = 0.f;
#pragma unroll
        for (int j = 0; j < 4; ++j) { v[j] = xr[64 * j]; w2[j] = xr2[64 * j]; }
#pragma unroll
        for (int j = 0; j < 4; ++j) { s += (v[j][0] * v[j][0] + v[j][1] * v[j][1]) + (v[j][2] * v[j][2] + v[j][3] * v[j][3]); s2 += (w2[j][0] * w2[j][0] + w2[j][1] * w2[j][1]) + (w2[j][2] * w2[j][2] + w2[j][3] * w2[j][3]); }
        s = wave_sum(s); s2 = wave_sum(s2);
        u32x2* o8 = (u32x2*)(XB + (size_t)m * DM) + lane;
#pragma unroll
        for (int j = 0; j < 4; ++j) { u32x2 w; w.x = cvt_pk_bf16(v[j][0], v[j][1]); w.y = cvt_pk_bf16(v[j][2], v[j][3]); o8[64 * j] = w; }
        if (lane < 16) SSQ[(size_t)m * 16 + lane] = (lane == 0) ? s : 0.f;
        if (m2 < MTOK) { u32x2* o82 = (u32x2*)(XB + (size_t)m2 * DM) + lane;
#pragma unroll
            for (int j = 0; j < 4; ++j) { u32x2 w; w.x = cvt_pk_bf16(w2[j][0], w2[j][1]); w.y = cvt_pk_bf16(w2[j][2], w2[j][3]); o82[64 * j] = w; }
            if (lane < 16) SSQ[(size_t)m2 * 16 + lane] = (lane == 0) ? s2 : 0.f; }
    }
    { float* TAB = (float*)(ws + WS_TAB); const float* tbl = a.in[23];
      for (int i = gw * 64 + lane; i < 8 * 128; i += NGW * 64) { const int h = i >> 7, d = i & 127; TAB[i] = tbl[(int)T5_BUCKET[d] * 8 + h] * LOG2E; } }
    { float* C1 = (float*)(ws + WS_C1);
      for (int o = gw; o < 256; o += NGW) { const int kv = o >> 7, n = o & 127; const float* pos = a.in[11 + kv]; const float* w1 = a.in[13 + 2 * kv]; float s = 0.f;
          for (int k = lane; k < 2048; k += 64) s += pos[k] * w1[(size_t)k * 128 + n];
          s = wave_sum(s); if (lane == 0) C1[o] = s; } }
}

constexpr int KVP = 144, KVT = 64 * KVP;
constexpr float NEG = -1.0e30f;
__device__ __forceinline__ int crow(int r, int h) { return (r & 3) + 8 * (r >> 2) + 4 * h; }
#define MFMA32(a, b, c) __builtin_amdgcn_mfma_f32_32x32x16_bf16((a), (b), (c), 0, 0, 0)
typedef short v4i16_t __attribute__((ext_vector_type(4)));
__device__ __forceinline__ s16x4 vtr(LAS const unsigned char* p) { return __builtin_bit_cast(s16x4, __builtin_amdgcn_ds_read_tr16_b64_v4i16((LAS v4i16_t*)p)); }

__device__ __forceinline__ void qk_tile(f32x16& p0, f32x16& p1, LAS const unsigned char* Kt, const bf16x8 (&qf)[4], int lane) {
    LAS const unsigned char* kp = Kt + (lane & 31) * KVP + 16 * (lane >> 5);
    f32x16 z = {}; p0 = z; p1 = z;
#pragma unroll
    for (int s = 0; s < 4; ++s) { const bf16x8 a0 = *(LAS const bf16x8*)(kp + 32 * s), a1 = *(LAS const bf16x8*)(kp + 32 * KVP + 32 * s);
        p0 = MFMA32(a0, qf[s], p0); p1 = MFMA32(a1, qf[s], p1); }
}
__device__ __forceinline__ void pv_tile(f32x16& o0, f32x16& o1, LAS const unsigned char* Vt, const bf16x8 (&pf)[4], int lane) {
    const int q = (lane & 15) >> 2, swz = ((q >> 1) & 1) * 64;
    LAS const unsigned char* vp0 = Vt + (4 * (lane >> 5) + q) * 128 + (((16 * ((lane >> 4) & 1) + 4 * (lane & 3)) * 2) ^ swz);
    LAS const unsigned char* vp1 = Vt + (4 * (lane >> 5) + q) * 128 + (((16 * ((lane >> 4) & 1) + 4 * (lane & 3)) * 2 + 64) ^ swz);
#pragma unroll
    for (int s = 0; s < 4; ++s) {
        const s16x4 l0 = vtr(vp0 + (16 * s) * 128), h0 = vtr(vp0 + (16 * s + 8) * 128), l1 = vtr(vp1 + (16 * s) * 128), h1 = vtr(vp1 + (16 * s + 8) * 128);
        const bf16x8 v0 = {l0[0], l0[1], l0[2], l0[3], h0[0], h0[1], h0[2], h0[3]}, v1 = {l1[0], l1[1], l1[2], l1[3], h1[0], h1[1], h1[2], h1[3]};
        o0 = MFMA32(v0, pf[s], o0); o1 = MFMA32(v1, pf[s], o1); }
}
__device__ __forceinline__ void pack_p(bf16x8 (&pf)[4], const f32x16& p0, const f32x16& p1) {
#pragma unroll
    for (int s = 0; s < 4; ++s) { const f32x16& p = (s < 2) ? p0 : p1; const int b = 8 * (s & 1);
        u32x4 w; w.x = cvt_pk_bf16(p[b], p[b + 1]); w.y = cvt_pk_bf16(p[b + 2], p[b + 3]); w.z = cvt_pk_bf16(p[b + 4], p[b + 5]); w.w = cvt_pk_bf16(p[b + 6], p[b + 7]);
        pf[s] = __builtin_bit_cast(bf16x8, w); }
}
struct FState { f32x16 o0, o1; float m, l; };
__device__ __forceinline__ void fstate_init(FState& st) { f32x16 z = {}; st.o0 = z; st.o1 = z; st.m = NEG; st.l = 0.f; }
#define MX3(a, b, c) __builtin_fmaxf(__builtin_fmaxf((a), (b)), (c))
__device__ __forceinline__ void softmax_pv(FState& st, f32x16& p0, f32x16& p1, LAS const unsigned char* Vt, int lane) {
    float a = MX3(p0[0], p0[1], p1[0]), b = MX3(p0[2], p0[3], p1[1]); a = MX3(a, p1[2], p1[3]);
#pragma unroll
    for (int r = 4; r < 16; r += 4) { a = MX3(a, p0[r], p0[r + 1]); b = MX3(b, p0[r + 2], p0[r + 3]); a = MX3(a, p1[r], p1[r + 1]); b = MX3(b, p1[r + 2], p1[r + 3]); }
    float mx = __builtin_fmaxf(a, b);
    mx = __builtin_fmaxf(mx, __shfl_xor(mx, 32));
    if (__any(mx > st.m + 8.0f)) {
        const float mn = (mx > st.m + 8.0f) ? mx : st.m, alpha = __builtin_amdgcn_exp2f(st.m - mn);
        st.l *= alpha; st.o0 *= alpha; st.o1 *= alpha; st.m = mn;
    }
    const float m = st.m; float s0 = 0.f, s1 = 0.f;
#pragma unroll
    for (int r = 0; r < 16; ++r) { p0[r] = __builtin_amdgcn_exp2f(p0[r] - m); p1[r] = __builtin_amdgcn_exp2f(p1[r] - m); s0 += p0[r]; s1 += p1[r]; }
    st.l += s0 + s1;
    bf16x8 pf[4]; pack_p(pf, p0, p1);
    pv_tile(st.o0, st.o1, Vt, pf, lane);
}
__device__ __forceinline__ u32x4 tile_ld(const bf16_t* base, int pitch, int tid) { return *(const u32x4*)(base + (size_t)(tid >> 3) * pitch + (tid & 7) * 8); }
__device__ __forceinline__ void tile_st(LAS unsigned char* T, u32x4 v, int tid) { *(LAS u32x4*)(T + (tid >> 3) * KVP + (tid & 7) * 16) = v; }
__device__ __forceinline__ void tile_st_v(LAS unsigned char* T, u32x4 v, int tid) { const int row = tid >> 3; *(LAS u32x4*)(T + row * 128 + (((tid & 7) * 16) ^ (((row >> 1) & 1) * 64))) = v; }

template <int MODE> __device__ __forceinline__ int pop_tile(unsigned& tiles) { int j; if (MODE == 2) { j = 31 - __builtin_clz(tiles); tiles &= ~(1u << j); } else { j = __builtin_ctz(tiles); tiles &= tiles - 1u; } return j; }
template <int MODE> __device__ __forceinline__ void flash_loop(FState& st, unsigned tiles, const bf16_t* Kg, const bf16_t* Vg, int pitch, LAS unsigned char* kvb, const bf16x8 (&qf)[4],
                                                               LAS const float* aux, int t, int R0, unsigned selbits, int tq, int tid, int lane) {
    if (tiles == 0u) return;
    const int h = lane >> 5;
    int cur = 0;
    int j0 = pop_tile<MODE>(tiles), j1 = tiles ? pop_tile<MODE>(tiles) : -1;
    { const u32x4 k = tile_ld(Kg + (size_t)(64 * j0) * pitch, pitch, tid), v = tile_ld(Vg + (size_t)(64 * j0) * pitch, pitch, tid);
      tile_st(kvb, k, tid); tile_st_v(kvb + KVT, v, tid); }
    u32x4 k1 = {}, v1 = {};
    if (j1 >= 0) { k1 = tile_ld(Kg + (size_t)(64 * j1) * pitch, pitch, tid); v1 = tile_ld(Vg + (size_t)(64 * j1) * pitch, pitch, tid); }
    __syncthreads();
    for (;;) {
        const int j = j0, j2 = tiles ? pop_tile<MODE>(tiles) : -1;
        u32x4 k2 = {}, v2 = {};
        if (j2 >= 0) { k2 = tile_ld(Kg + (size_t)(64 * j2) * pitch, pitch, tid); v2 = tile_ld(Vg + (size_t)(64 * j2) * pitch, pitch, tid); }
        LAS unsigned char* Kt = kvb + cur * 2 * KVT; LAS unsigned char* Vt = Kt + KVT;
        const bool act = (MODE == 0) ? (64 * j <= R0 + 31) : true;
        if (act) {
            f32x16 p0, p1; qk_tile(p0, p1, Kt, qf, lane);
            const int kb = 64 * j + 4 * h;
            if (MODE == 0) {
#pragma unroll
                for (int g4 = 0; g4 < 4; ++g4) { const f32x4 c0 = *(LAS const f32x4*)(aux + kb + 8 * g4), c1 = *(LAS const f32x4*)(aux + kb + 8 * g4 + 32);
#pragma unroll
                    for (int i = 0; i < 4; ++i) { p0[4 * g4 + i] += c0[i]; p1[4 * g4 + i] += c1[i]; } }
                if (64 * j + 63 > R0) {
#pragma unroll
                    for (int r = 0; r < 16; ++r) { const int kp = kb + (r & 3) + 8 * (r >> 2); if (kp > t) p0[r] = NEG; if (kp + 32 > t) p1[r] = NEG; } }
            } else {
                const bool sel = (MODE == 2) || ((selbits >> j) & 1u);
                if (j + 3 <= tq) { const float c31 = sel ? aux[127 + 64] : NEG;
#pragma unroll
                    for (int r = 0; r < 16; ++r) { p0[r] += c31; p1[r] += c31; }
                } else { LAS const float* ab = aux + (t - kb + 1);
#pragma unroll
                    for (int r = 0; r < 16; ++r) { p0[r] += ab[63 - ((r & 3) + 8 * (r >> 2))]; p1[r] += ab[31 - ((r & 3) + 8 * (r >> 2))]; }
                    if (MODE == 1 && !sel) {
#pragma unroll
                        for (int r = 0; r < 16; ++r) { p0[r] = NEG; p1[r] = NEG; } }
                }
                if (MODE == 1) {
                    if (j == tq) {
#pragma unroll
                        for (int r = 0; r < 16; ++r) { const int kp = kb + (r & 3) + 8 * (r >> 2); if (kp > t) p0[r] = NEG; if (kp + 32 > t) p1[r] = NEG; } }
                } else {
                    if (j == tq || j + 8 == tq) {
#pragma unroll
                        for (int r = 0; r < 16; ++r) { const int d0 = t - (kb + (r & 3) + 8 * (r >> 2)), d1 = d0 - 32; if (d0 < 0 || d0 >= 512) p0[r] = NEG; if (d1 < 0 || d1 >= 512) p1[r] = NEG; } }
                }
            }
            softmax_pv(st, p0, p1, Vt, lane);
        }
        if (j1 >= 0) { LAS unsigned char* Kn = kvb + (cur ^ 1) * 2 * KVT; tile_st(Kn, k1, tid); tile_st_v(Kn + KVT, v1, tid); }
        __syncthreads();
        if (j1 < 0) break;
        j0 = j1; j1 = j2; k1 = k2; v1 = v2; cur ^= 1;
    }
}
__device__ __forceinline__ void store_ot(bf16_t* orow, const f32x16& o0, const f32x16& o1, int h) {
#pragma unroll
    for (int g4 = 0; g4 < 4; ++g4) { u32x2 w0, w1; w0.x = cvt_pk_bf16(o0[4 * g4], o0[4 * g4 + 1]); w0.y = cvt_pk_bf16(o0[4 * g4 + 2], o0[4 * g4 + 3]); w1.x = cvt_pk_bf16(o1[4 * g4], o1[4 * g4 + 1]); w1.y = cvt_pk_bf16(o1[4 * g4 + 2], o1[4 * g4 + 3]);
        *(u32x2*)(orow + 8 * g4 + 4 * h) = w0; *(u32x2*)(orow + 32 + 8 * g4 + 4 * h) = w1; }
}

__device__ __forceinline__ void compress_unit(int U, const Args& a, LAS unsigned char* lds, int tid, int wave, int lane) {
    unsigned char* ws = a.ws;
    const int kv = U & 1, ct = (U >> 1) & 3, g = (U >> 3) & 1, b = U >> 4;
    const bf16_t* SRC = (const bf16_t*)(ws + WS_A + (kv ? A_VC : A_KC));
    const bf16_t* W1T = (const bf16_t*)(ws + (kv ? WS_CW1V : WS_CW1K));
    const bf16_t* W2T = (const bf16_t*)(ws + (kv ? WS_CW2V : WS_CW2K));
    const float* C1 = (const float*)(ws + WS_C1) + 128 * kv;
    bf16_t* DST = (bf16_t*)(ws + (kv ? WS_VCMP : WS_KCMP)) + (size_t)((b * 2 + g) * 128 + 32 * ct) * 64;
    LAS float* hid = (LAS float*)lds;
    LAS unsigned char* hb = lds + 16640;
    LAS float* out2 = (LAS float*)(lds + 16640 + 8704);
    const int nt = wave & 3, kh = wave >> 2, i = lane & 31, h = lane >> 5;
    const int c = min(32 * ct + i, 126);
    const bf16_t* arow = SRC + (size_t)(b * SEQ + 16 * c + 16 * kh) * 128 + 64 * g + 8 * h;
    const bf16_t* brow = W1T + (size_t)(32 * nt + i) * 2048 + (16 * kh) * 64 + 8 * h;
    f32x16 acc = {};
#pragma unroll 4
    for (int lt = 0; lt < 16; ++lt)
#pragma unroll
        for (int s = 0; s < 4; ++s) { const bf16x8 av = *(const bf16x8*)(arow + lt * 128 + 16 * s), bv = *(const bf16x8*)(brow + lt * 64 + 16 * s); acc = MFMA32(av, bv, acc); }
    if (kh == 1) {
#pragma unroll
        for (int r = 0; r < 16; ++r) hid[crow(r, h) * 129 + 32 * nt + i] = acc[r];
    }
    __syncthreads();
    if (kh == 0) { const float c1 = C1[32 * nt + i];
#pragma unroll
        for (int r = 0; r < 16; ++r) { const float v = acc[r] + hid[crow(r, h) * 129 + 32 * nt + i] + c1; const float sv = pg8::silu_f(v);
            *(LAS bf16_t*)(hb + crow(r, h) * 272 + (32 * nt + i) * 2) = (bf16_t)(cvt_pk_bf16(sv, 0.f) & 0xffffu); }
    }
    __syncthreads();
    if (wave < 2) { f32x16 a2 = {};
#pragma unroll
        for (int s = 0; s < 8; ++s) { const bf16x8 av = *(LAS const bf16x8*)(hb + i * 272 + (16 * s + 8 * h) * 2), bv = *(const bf16x8*)(W2T + (size_t)(32 * wave + i) * 128 + 16 * s + 8 * h); a2 = MFMA32(av, bv, a2); }
#pragma unroll
        for (int r = 0; r < 16; ++r) out2[crow(r, h) * 65 + 32 * wave + i] = a2[r];
    }
    __syncthreads();
    { const int cl = tid >> 4, e4 = (tid & 15) * 4; float v[4]; float ss = 0.f;
#pragma unroll
      for (int q = 0; q < 4; ++q) { v[q] = out2[cl * 65 + e4 + q]; ss += v[q] * v[q]; }
      if (kv == 0) { ss += __shfl_xor(ss, 1); ss += __shfl_xor(ss, 2); ss += __shfl_xor(ss, 4); ss += __shfl_xor(ss, 8);
          const float rs = __builtin_amdgcn_rsqf(ss * (1.0f / 64.0f) + RMS_EPS); const float* gn = a.in[8];
#pragma unroll
          for (int q = 0; q < 4; ++q) v[q] = v[q] * rs * gn[e4 + q]; }
      if (32 * ct + cl >= 127) { v[0] = 0.f; v[1] = 0.f; v[2] = 0.f; v[3] = 0.f; }
      u32x2 w; w.x = cvt_pk_bf16(v[0], v[1]); w.y = cvt_pk_bf16(v[2], v[3]); *(u32x2*)(DST + (size_t)cl * 64 + e4) = w; }
    __syncthreads();
}

__device__ __forceinline__ void fox_unit(int b, int hh, int qb, const Args& a, LAS unsigned char* lds, int tid, int wave, int lane) {
    unsigned char* ws = a.ws;
    const bf16_t* QB = (const bf16_t*)(ws + WS_A + A_QB); const bf16_t* KB = (const bf16_t*)(ws + WS_A + A_KB); const bf16_t* VB = (const bf16_t*)(ws + WS_A + A_VB);
    const float* LF = (const float*)(ws + WS_LF); bf16_t* OF = (bf16_t*)(ws + WS_A + A_QB);
    LAS float* cum2 = (LAS float*)(lds + 4 * KVT); LAS float* wsum = (LAS float*)(lds + 4 * KVT + 8192);
    const int nrows = 256 * (qb + 1), h = lane >> 5;
    { float v[4];
#pragma unroll
      for (int i = 0; i < 4; ++i) { const int s = 4 * tid + i; v[i] = (s < nrows) ? LF[(size_t)(b * SEQ + s) * 8 + hh] : 0.f; }
      v[1] += v[0]; v[2] += v[1]; v[3] += v[2];
      float tot = v[3];
#pragma unroll
      for (int off = 1; off < 64; off <<= 1) { const float tt = __shfl_up(tot, off); if (lane >= off) tot += tt; }
      if (lane == 63) wsum[wave] = tot;
      __syncthreads();
      float base = 0.f;
      for (int i = 0; i < wave; ++i) base += wsum[i];
      const float excl = (tot - v[3]) + base;
#pragma unroll
      for (int i = 0; i < 4; ++i) cum2[4 * tid + i] = (v[i] + excl) * (-LOG2E);
      __syncthreads(); }
    const int R0 = 256 * qb + 32 * wave, t = R0 + (lane & 31); const size_t row = (size_t)b * SEQ + t;
    bf16x8 qf[4];
#pragma unroll
    for (int s = 0; s < 4; ++s) qf[s] = *(const bf16x8*)(QB + row * 512 + hh * 64 + 16 * s + 8 * h);
    FState st; fstate_init(st);
    const unsigned tiles = (qb == 7) ? 0xffffffffu : ((1u << (4 * qb + 4)) - 1u);
    flash_loop<0>(st, tiles, KB + (size_t)b * SEQ * 512 + hh * 64, VB + (size_t)b * SEQ * 512 + hh * 64, 512, lds, qf, cum2, t, R0, 0u, 0, tid, lane);
    float l = st.l + __shfl_xor(st.l, 32); const float inv = (l > 0.f) ? 1.0f / l : 0.f;
    st.o0 *= inv; st.o1 *= inv;
    store_ot(OF + row * 512 + hh * 64, st.o0, st.o1, h);
    __syncthreads();
}

constexpr int NL_CMP = 4 * KVT, NL_IMP = 8 * KVT, NL_SEL = NL_IMP + 4 * 64 * 33 * 4, NL_UNI = NL_SEL + 256, NL_TAB = NL_SEL + 512;
__device__ __forceinline__ void nsa_unit(int b, int g, int tq, const Args& a, LAS unsigned char* lds, int tid, int wave, int lane) {
    unsigned char* ws = a.ws;
    const bf16_t* QA = (const bf16_t*)(ws + WS_A + A_QA);
    const bf16_t* KS = (const bf16_t*)(ws + WS_A + A_KS); const bf16_t* VS = (const bf16_t*)(ws + WS_A + A_VS);
    const bf16_t* KW = (const bf16_t*)(ws + WS_A + A_KW); const bf16_t* VW = (const bf16_t*)(ws + WS_A + A_VW);
    const bf16_t* KCM = (const bf16_t*)(ws + WS_KCMP) + (size_t)(b * 2 + g) * 128 * 64; const bf16_t* VCM = (const bf16_t*)(ws + WS_VCMP) + (size_t)(b * 2 + g) * 128 * 64;
    const float* GA = (const float*)(ws + WS_GA); bf16_t* ON = (bf16_t*)(ws + WS_A + A_QA);
    LAS unsigned char* cmpb = lds + NL_CMP;
    LAS float* imp = (LAS float*)(lds + NL_IMP);
    LAS unsigned* selm = (LAS unsigned*)(lds + NL_SEL); LAS unsigned* uni = (LAS unsigned*)(lds + NL_UNI);
    const int hr = wave >> 1, th = wave & 1, head = 4 * g + hr, h = lane >> 5, tl = 32 * th + (lane & 31), t = 64 * tq + tl;
    const size_t row = (size_t)b * SEQ + t;
    LAS const float* tabh = (LAS const float*)(lds + NL_TAB) + 320 * head;
    bf16x8 qf[4];
#pragma unroll
    for (int s = 0; s < 4; ++s) qf[s] = *(const bf16x8*)(QA + row * 512 + head * 64 + 16 * s + 8 * h);
    const int nct = (4 * tq + 3 > 64) ? 2 : 1;
    for (int i = 0; i < nct; ++i) { tile_st(cmpb + i * KVT, tile_ld(KCM + (size_t)i * 64 * 64, 64, tid), tid); tile_st_v(cmpb + (2 + i) * KVT, tile_ld(VCM + (size_t)i * 64 * 64, 64, tid), tid); }
    if (tid == 0) uni[0] = 0u;
    __syncthreads();
    f32x16 acc0, acc1;
    {
#define CMP_LOGITS(ti) do { qk_tile(p0, p1, cmpb + (ti) * KVT, qf, lane); \
            _Pragma("unroll") for (int r = 0; r < 16; ++r) { const int c = 64 * (ti) + crow(r, h); const int d0 = t - (16 * c + 31), d1 = d0 - 512; \
                p0[r] = (d0 >= 0) ? p0[r] + tabh[min(d0, 127) + 64] : NEG; p1[r] = (d1 >= 0) ? p1[r] + tabh[min(d1, 127) + 64] : NEG; } } while (0)
        f32x16 p0, p1; float mx = NEG, sum = 0.f;
#define CMP_PASS1(ti) do { CMP_LOGITS(ti); float tm = fmaxf(p0[0], p1[0]); _Pragma("unroll") for (int r = 1; r < 16; ++r) tm = fmaxf(tm, fmaxf(p0[r], p1[r])); \
            tm = fmaxf(tm, __shfl_xor(tm, 32)); const float mn = fmaxf(mx, tm); float sacc = 0.f; \
            _Pragma("unroll") for (int r = 0; r < 16; ++r) { sacc += ((p0[r] > -1.0e29f) ? __builtin_amdgcn_exp2f(p0[r] - mn) : 0.f) + ((p1[r] > -1.0e29f) ? __builtin_amdgcn_exp2f(p1[r] - mn) : 0.f); } \
            sum = sum * __builtin_amdgcn_exp2f(mx - mn) + sacc; mx = mn; } while (0)
        CMP_PASS1(0);
        if (nct > 1) CMP_PASS1(1);
        sum += __shfl_xor(sum, 32);
        const float inv = (sum > 0.f) ? 1.0f / sum : 0.f;
        f32x16 z = {}; acc0 = z; acc1 = z;
        LAS float* ip = imp + (hr * 64 + tl) * 33 + h; float carry = 0.f;
#define IMP_TILE(P, T) _Pragma("unroll") for (int qd = 0; qd < 4; ++qd) { const float own = (P[4 * qd] + P[4 * qd + 1]) + (P[4 * qd + 2] + P[4 * qd + 3]); const float rc = __shfl_xor(P[4 * qd + 3], 32); \
              ip[2 * (4 * (T) + qd)] = own + (h ? rc : carry); carry = rc; }
#define CMP_PASS2(ti) do { CMP_LOGITS(ti); \
            _Pragma("unroll") for (int r = 0; r < 16; ++r) { p0[r] = (p0[r] > -1.0e29f) ? __builtin_amdgcn_exp2f(p0[r] - mx) * inv : 0.f; p1[r] = (p1[r] > -1.0e29f) ? __builtin_amdgcn_exp2f(p1[r] - mx) * inv : 0.f; } \
            IMP_TILE(p0, 2 * (ti)) IMP_TILE(p1, 2 * (ti) + 1) \
            bf16x8 pf[4]; pack_p(pf, p0, p1); pv_tile(acc0, acc1, cmpb + (2 + (ti)) * KVT, pf, lane); } while (0)
        CMP_PASS2(0);
        if (nct > 1) CMP_PASS2(1);
#undef CMP_LOGITS
#undef CMP_PASS1
#undef CMP_PASS2
#undef IMP_TILE
        const float g_c = GA[row * 24 + head];
        acc0 *= g_c; acc1 *= g_c;
    }
    __syncthreads();
    if (tid < 64) {
        LAS float* r0 = imp + tid * 33;
        for (int j = 0; j <= tq; ++j) { float s = (r0[j] + imp[(64 + tid) * 33 + j]) + (imp[(128 + tid) * 33 + j] + imp[(192 + tid) * 33 + j]); r0[j] = s; }
        unsigned sel = 1u | (1u << tq); if (tq > 0) sel |= 1u << (tq - 1);
        const int need = 8 - __builtin_popcount(sel);
        for (int it = 0; it < need; ++it) { int best = -1; float bv = -3.0e38f;
            for (int j = 0; j <= tq; ++j) { if (!((sel >> j) & 1u)) { const float v = r0[j]; if (v > bv) { bv = v; best = j; } } }
            if (best >= 0) sel |= 1u << best; }
        selm[tid] = sel; atomicOr((unsigned*)uni, sel);
    }
    __syncthreads();
    const unsigned selbits = selm[tl], utiles = uni[0];
    { FState st; fstate_init(st);
      flash_loop<1>(st, utiles, KS + (size_t)b * SEQ * 128 + 64 * g, VS + (size_t)b * SEQ * 128 + 64 * g, 128, lds, qf, tabh, t, 0, selbits, tq, tid, lane);
      float l = st.l + __shfl_xor(st.l, 32); int l2 = lane; asm volatile("" : "+v"(l2)); const size_t row2 = (size_t)b * SEQ + 64 * tq + 32 * th + (l2 & 31);
      const float g_s = GA[row2 * 24 + 8 + head]; const float sc = (l > 0.f) ? g_s / l : 0.f;
      acc0 += st.o0 * sc; acc1 += st.o1 * sc; }
    { FState st; fstate_init(st);
      const int jlo = max(tq - 8, 0); const unsigned hi = (tq == 31) ? 0xffffffffu : ((1u << (tq + 1)) - 1u); const unsigned wt = hi & ~((1u << jlo) - 1u);
      flash_loop<2>(st, wt, KW + (size_t)b * SEQ * 128 + 64 * g, VW + (size_t)b * SEQ * 128 + 64 * g, 128, lds, qf, tabh, t, 0, 0u, tq, tid, lane);
      float l = st.l + __shfl_xor(st.l, 32); int l2 = lane; asm volatile("" : "+v"(l2)); const size_t row2 = (size_t)b * SEQ + 64 * tq + 32 * th + (l2 & 31);
      const float g_w = GA[row2 * 24 + 16 + head]; const float sc = (l > 0.f) ? g_w / l : 0.f;
      acc0 += st.o0 * sc; acc1 += st.o1 * sc;
      store_ot(ON + row2 * 512 + head * 64, acc0, acc1, l2 >> 5); }
    __syncthreads();
}
#define XB_TMO      128
#define XB_XCNT(j)  (256  + 64 * (j))
#define XB_XSUB(j)  (1280 + 64 * (j))
#define XB_XGEN(j)  (2304 + 64 * (j))
#define XB_TOP      3328
#define XB_TOPGEN   3392
#define XCD_BAR_WORDS 3456
#define XB_SPIN_CAP (1u << 18)

__device__ __forceinline__ unsigned xb_ld(unsigned* p)              { return __hip_atomic_load(p, __ATOMIC_RELAXED, __HIP_MEMORY_SCOPE_AGENT); }
__device__ __forceinline__ unsigned xb_add(unsigned* p, unsigned v) { return __hip_atomic_fetch_add(p, v, __ATOMIC_RELAXED, __HIP_MEMORY_SCOPE_AGENT); }
__device__ __forceinline__ unsigned xb_xcc_id() { return (unsigned)__builtin_amdgcn_s_getreg((3 << 11) | 20) & 0xFu; }
#define XB_SPIN(cond, bar) do { unsigned _sp = 0; while (cond) { __builtin_amdgcn_s_sleep(1); \
    if ((++_sp & 255u) == 0u) { if (xb_ld(&(bar)[XB_TMO])) break; if (_sp > XB_SPIN_CAP) { atomicAdd(&(bar)[XB_TMO], 1u); break; } } } } while (0)

struct XcdBarrier {
    unsigned* bar; unsigned x;
    volatile LAS unsigned* st;
};

__device__ __forceinline__ XcdBarrier xcd_barrier_post(unsigned* bar, volatile LAS unsigned* st, int tid) {
    XcdBarrier b; b.bar = bar; b.x = xb_xcc_id(); b.st = st;
    if (tid == 0) (void)xb_add(&bar[XB_XCNT(b.x)], 1u);
    return b;
}
__device__ __forceinline__ void xcd_barrier_complete(unsigned* bar, unsigned x, unsigned& nloc, unsigned& nx) {
    const unsigned G = gridDim.x;
    unsigned sum, cnt, mine, sp = 0u;
    for (;;) {
        sum = 0u; cnt = 0u; mine = 0u;
#pragma unroll
        for (unsigned j = 0; j < 16; ++j) { const unsigned c = xb_ld(&bar[XB_XCNT(j)]); sum += c; cnt += (c > 0u) ? 1u : 0u; mine = (j == x) ? c : mine; }
        if (sum == G) break;
        __builtin_amdgcn_s_sleep(1);
        if ((++sp & 255u) == 0u) { if (xb_ld(&bar[XB_TMO])) break; if (sp > XB_SPIN_CAP) { atomicAdd(&bar[XB_TMO], 1u); break; } }
    }
    nloc = mine > 0u ? mine : 1u; nx = cnt > 0u ? cnt : 1u;
}

__device__ __forceinline__ void xcd_barrier(const XcdBarrier& b, int tid) {
    asm volatile("s_waitcnt vmcnt(0)" ::: "memory");
    __syncthreads();
    if (tid == 0) {
        unsigned* bar = b.bar;
        __builtin_amdgcn_s_waitcnt(0);
        unsigned nloc = b.st[0], nx = b.st[1];
        if (nloc == 0u) { xcd_barrier_complete(bar, b.x, nloc, nx); b.st[0] = nloc; b.st[1] = nx; }
        const unsigned old = xb_add(&bar[XB_XSUB(b.x)], 1u);
        const unsigned gen = old / nloc;
        if (old + 1u == (gen + 1u) * nloc) {
            __builtin_amdgcn_fence(__ATOMIC_RELEASE, "agent");
            asm volatile("s_waitcnt vmcnt(0)" ::: "memory");
            const unsigned og = xb_add(&bar[XB_TOP], 1u);
            const unsigned tg = og / nx;
            if (og + 1u == (tg + 1u) * nx) xb_add(&bar[XB_TOPGEN], 1u);
            else XB_SPIN(xb_ld(&bar[XB_TOPGEN]) == tg, bar);
            __builtin_amdgcn_fence(__ATOMIC_ACQUIRE, "agent");
            xb_add(&bar[XB_XGEN(b.x)], 1u);
            asm volatile("s_waitcnt vmcnt(0)" ::: "memory");
        } else {
            XB_SPIN(xb_ld(&bar[XB_XGEN(b.x)]) == gen, bar);
            __builtin_amdgcn_fence(__ATOMIC_ACQUIRE, "agent");
            asm volatile("s_waitcnt vmcnt(0)" ::: "memory");
        }
    }
    __syncthreads();
}

constexpr int NPHASE = 11;
#ifndef PHMASK
#define PHMASK 0xfff
#endif
#ifndef MK_MULTI_LAUNCH
#define MK_MULTI_LAUNCH 0
#endif
__global__ void __launch_bounds__(NTHREADS, 2) fwd_kernel(Args a) {
    extern __shared__ __attribute__((aligned(16))) unsigned char lds_raw[];
    LAS unsigned char* lds = (LAS unsigned char*)lds_raw;
    const int G = gridDim.x, bx = blockIdx.x, vcu = (G % 8 == 0) ? (bx % 8) * (G / 8) + bx / 8 : bx;
    unsigned char* const ws = a.ws;
#define P_XB ((bf16_t*)(ws + WS_XB))
#define P_HB ((bf16_t*)(ws + WS_A))
#define P_MERGED ((bf16_t*)(ws + WS_A + A_KB))
#define P_SSQ ((float*)(ws + WS_SSQ))
#define P_GM ((bf16_t*)(ws + WS_A + A_GM))
    const int lo = a.ph_lo, hi = a.ph_hi;
    const int wave_s = __builtin_amdgcn_readfirstlane(threadIdx.x >> 6);
#define MYTID() (wave_s * 64 + (int)__builtin_amdgcn_mbcnt_hi(~0u, __builtin_amdgcn_mbcnt_lo(~0u, 0u)))
#define IN(k) (lo <= (k) && (k) < hi)

#define GRID_BARRIER() do { XcdBarrier bar_; bar_.bar = (unsigned*)ws; bar_.x = xb_xcc_id(); bar_.st = (volatile LAS unsigned*)(lds + 131072); xcd_barrier(bar_, MYTID()); } while (0)
#define SYNC_AFTER(k) do { if (IN(k) && IN((k) + 1)) GRID_BARRIER(); } while (0)
#define OPAQUE_TID() int tid = MYTID(); asm volatile("" : "+v"(tid)); const int lane = tid & 63, wave = __builtin_amdgcn_readfirstlane(tid >> 6); (void)lane; (void)wave
#define GEMM_SWIGLU(k, WOFF) if (IN(k)) { pg8::Gemm g{P_XB, (const bf16_t*)(ws + (WOFF)), MTOK, NUP, DM}; pg8::StaticOrder S; S.init(MTOK, NUP, G, bx); pg8::EpiSwiGLU E{P_HB, DFF, P_SSQ}; \
        pg8::gemm_phase<pg8::EpiSwiGLU, pg8::StaticOrder, true, true>(lds, g, S, E, MYTID()); }
#define GEMM_RESID(k, APTR, WOFF, KDIM, BF, BB, OF, OB, ALPHA, SSQP) if (IN(k)) { pg8::Gemm g{(APTR), (const bf16_t*)(ws + (WOFF)), MTOK, DM, (KDIM)}; pg8::StaticOrder S; S.init(MTOK, DM, G, bx); \
        pg8::EpiResid E{(BF), (BB), (OF), (OB), (ALPHA), (SSQP)}; pg8::gemm_phase<pg8::EpiResid, pg8::StaticOrder, true, true>(lds, g, S, E, MYTID()); }
#define GEMM_GATE(k, APTR, WOFF, GOFF, FIRST) if (IN(k)) { pg8::Gemm g{(APTR), (const bf16_t*)(ws + (WOFF)), MTOK, DM, 512}; pg8::StaticOrder S; S.init(MTOK, DM, G, bx); \
        pg8::EpiGate E{P_MERGED, P_GM, (GOFF), (FIRST)}; pg8::gemm_phase<pg8::EpiGate, pg8::StaticOrder, true, true>(lds, g, S, E, MYTID()); }
    { volatile LAS unsigned* stw = (volatile LAS unsigned*)(lds + 131072); if (threadIdx.x == 0) { stw[0] = 0u; stw[1] = 0u; } __syncthreads(); }
    (void)xcd_barrier_post((unsigned*)ws, (volatile LAS unsigned*)(lds + 131072), (int)threadIdx.x);
    if (IN(0)) { OPAQUE_TID(); prep_phase(a, lds, vcu, G, wave, lane); }
    if (IN(0) && IN(1)) cg::this_grid().sync();
    GEMM_SWIGLU(1, WS_WUP1)
    SYNC_AFTER(1);
    GEMM_RESID(2, P_HB, WS_WDN1, DFF, a.in[0], (const bf16_t*)nullptr, (float*)nullptr, P_XB, 0.5f, P_SSQ)
    SYNC_AFTER(2);
    if (IN(3)) {
        pg8::Gemm g{P_XB, (const bf16_t*)(ws + WS_WIN), MTOK, NIN, DM}; pg8::StaticOrder S; S.init(MTOK, NIN, G, bx);
        pg8::EpiProj E; unsigned char* A = ws + WS_A;
        E.P.QA = (bf16_t*)(A + A_QA); E.P.KC = (bf16_t*)(A + A_KC); E.P.VC = (bf16_t*)(A + A_VC); E.P.KS = (bf16_t*)(A + A_KS); E.P.VS = (bf16_t*)(A + A_VS); E.P.KW = (bf16_t*)(A + A_KW); E.P.VW = (bf16_t*)(A + A_VW);
        E.P.QB = (bf16_t*)(A + A_QB); E.P.KB = (bf16_t*)(A + A_KB); E.P.VB = (bf16_t*)(A + A_VB); E.P.GM = P_GM; E.P.GA = (float*)(ws + WS_GA); E.P.LF = (float*)(ws + WS_LF);
        E.ssq = P_SSQ; E.nsa_q_gain = a.in[7]; E.nsa_k_gain = a.in[8]; E.fox_q_gain = a.in[9]; E.fox_k_gain = a.in[10]; E.b_forget = a.in[6];
        pg8::gemm_phase<pg8::EpiProj, pg8::StaticOrder, true, true>(lds, g, S, E, MYTID());
    }
    SYNC_AFTER(3);
    if (IN(4)) { OPAQUE_TID();
        for (int U = vcu; U < 256; U += G) { int tu = tid; asm volatile("" : "+v"(tu)); compress_unit(U, a, lds, tu, wave, tu & 63); }
        for (int U = vcu; U < 1024; U += G) { const int i = U >> 8, v = U & 255, bh = v >> 1, half = v & 1; const int qb = (i == 0) ? half : (i == 1) ? 7 - half : (i == 2) ? 2 + half : 5 - half;
            int tu = tid; asm volatile("" : "+v"(tu)); fox_unit(bh >> 3, bh & 7, qb, a, lds, tu, wave, tu & 63); }
    }
    SYNC_AFTER(4);
    if (IN(5)) { OPAQUE_TID();
        { const float* TAB = (const float*)(ws + WS_TAB); LAS float* tl = (LAS float*)(lds + NL_TAB); for (int i = tid; i < 8 * 320; i += NTHREADS) { const int hd = i / 320, d = i % 320 - 64; tl[i] = TAB[hd * 128 + min(max(d, 0), 127)]; } }
        __syncthreads();
        for (int U = vcu; U < 1024; U += G) { const int i = U >> 8, v = U & 255, bg = v >> 3, s = v & 7; const int tq = (i == 0) ? s : (i == 1) ? 15 - s : (i == 2) ? 16 + s : 31 - s;
            int tu = tid; asm volatile("" : "+v"(tu)); nsa_unit(bg >> 1, bg & 1, tq, a, lds, tu, wave, tu & 63); }
    }
    SYNC_AFTER(5);
    GEMM_GATE(6, (bf16_t*)(ws + WS_A + A_QA), WS_WON, 0, true)
    GEMM_GATE(7, (bf16_t*)(ws + WS_A + A_QB), WS_WOF, 1024, false)
    SYNC_AFTER(7);
    GEMM_RESID(8, P_MERGED, WS_WOUT, DM, (const float*)nullptr, P_XB, (float*)nullptr, P_XB, 1.0f, P_SSQ)
    SYNC_AFTER(8);
    GEMM_SWIGLU(9, WS_WUP2)
    SYNC_AFTER(9);
    GEMM_RESID(10, P_HB, WS_WDN2, DFF, (const float*)nullptr, P_XB, a.out, (bf16_t*)nullptr, 0.5f, (float*)nullptr)
}

extern "C" void kernel_launch(void* const* d_in, const int* in_sizes, int n_in, void* d_out, int out_size, void* d_ws, size_t ws_size, hipStream_t stream) {
    static int grid = 0;
    if (grid == 0) {
        if (n_in != 24 || in_sizes[0] != MTOK * DM || out_size != MTOK * DM || ws_size < WS_END) { fprintf(stderr, "kernel_launch: unexpected shapes (n_in %d, in0 %d, out %d, ws %zu < %zu)\n", n_in, n_in > 0 ? in_sizes[0] : -1, out_size, ws_size, (size_t)WS_END); grid = -1; return; }
        int dev = 0, cus = 0, per_cu = 0;
        if (hipGetDevice(&dev) != hipSuccess || hipDeviceGetAttribute(&cus, hipDeviceAttributeMultiprocessorCount, dev) != hipSuccess) { grid = -1; return; }
        if (hipFuncSetAttribute((const void*)fwd_kernel, hipFuncAttributeMaxDynamicSharedMemorySize, LDS_BYTES) != hipSuccess) { fprintf(stderr, "kernel_launch: hipFuncSetAttribute failed\n"); grid = -1; return; }
        if (hipOccupancyMaxActiveBlocksPerMultiprocessor(&per_cu, (const void*)fwd_kernel, NTHREADS, LDS_BYTES) != hipSuccess || per_cu < 1) { fprintf(stderr, "kernel_launch: occupancy query reports %d blocks per CU\n", per_cu); (void)hipGetLastError(); grid = -1; return; }
        grid = cus;
    }
    if (grid < 0) return;
    if (hipMemsetAsync(d_ws, 0, 65536, stream) != hipSuccess) { fprintf(stderr, "kernel_launch: memset of the control words failed\n"); return; }
    Args a{};
    for (int i = 0; i < 24; ++i) a.in[i] = (const float*)d_in[i];
    a.out = (float*)d_out; a.ws = (unsigned char*)d_ws;
#if MK_MULTI_LAUNCH
    for (int ph = 0; ph < NPHASE; ++ph) { a.ph_lo = ph; a.ph_hi = ph + 1; hipLaunchKernelGGL(fwd_kernel, dim3(grid), dim3(NTHREADS), LDS_BYTES, stream, a); }
#else
    a.ph_lo = 0; a.ph_hi = NPHASE;
    void* args[] = {&a};
    const hipError_t e = hipLaunchCooperativeKernel((const void*)fwd_kernel, dim3(grid), dim3(NTHREADS), args, LDS_BYTES, stream);
    if (e != hipSuccess) fprintf(stderr, "kernel_launch: cooperative launch failed: %s (grid %d)\n", hipGetErrorString(e), grid);
#endif
}
```

```cpp
#include <hip/hip_runtime.h>
#include <hip/hip_cooperative_groups.h>
#include <cstdio>
#include <cstdint>
namespace cg = cooperative_groups;

namespace pg8 {
#define PG8_LAS __attribute__((address_space(3)))
typedef unsigned short bf16_t;
typedef short bf16x8 __attribute__((ext_vector_type(8)));
typedef float f32x4 __attribute__((ext_vector_type(4)));
typedef unsigned u32x4 __attribute__((ext_vector_type(4)));
constexpr int BM = 256, BK = 64, HALF = 128, HTB = HALF * BK * 2  , STAGE_BYTES = 8 * HTB, NXCD = 8, WGM = 8;

__host__ __device__ __forceinline__ int lds_byte(int r, int c) { const int st = (r >> 4) * 2 + (c >> 5), rr = r & 15, cc = c & 31, ob = rr * 64 + cc * 2; return st * 1024 + (ob ^ (((ob >> 9) & 1) << 5)); }
__host__ __device__ __forceinline__ void stage_rc(int b, int& R, int& C) { const int st = b / 1024, sb = b % 1024, swz = sb ^ (((sb >> 9) & 1) << 5); R = (st >> 1) * 16 + swz / 64; C = (st & 1) * 32 + (swz % 64) / 2; }
__host__ __device__ __forceinline__ int perm32(int rho) { const int n = rho >> 4, i = rho & 15; return 8 * (i >> 2) + 4 * n + (i & 3); }

struct Unit { int pm, pn; };
struct Gemm { const bf16_t* A; const bf16_t* Bt; int M, N, K; };

struct StaticOrder {
    int nM, nN, nwg, G, c;
    __host__ __device__ void init(int M, int N, int G_, int c_) { nM = M / BM; nN = N / BM; nwg = nM * nN; G = G_; c = c_; }
    __host__ __device__ bool next(int i, Unit& u) const {
        const long L = (long)i * G + c; if (L >= nwg) return false;
        int wgid = (int)L; { const int q = nwg / NXCD, r = nwg % NXCD, xcd = wgid % NXCD, off = wgid / NXCD; wgid = (xcd < r ? xcd * (q + 1) : r * (q + 1) + (xcd - r) * q) + off; }
        const int nig = WGM * nN, gid = wgid / nig, fm = gid * WGM, gsz = (nM - fm) < WGM ? (nM - fm) : WGM;
        u.pm = fm + ((wgid % nig) % gsz); u.pn = (wgid % nig) / gsz; return true;
    }
    __device__ __forceinline__ void a_ready(const Unit&) const {}
    __device__ __forceinline__ void done(const Unit&) const {}
};

typedef float f32x2 __attribute__((ext_vector_type(2)));
typedef __bf16 bf16x2_t __attribute__((ext_vector_type(2)));
typedef unsigned u32x2 __attribute__((ext_vector_type(2)));
__device__ __forceinline__ unsigned cvt_pk_bf16(float lo, float hi) { f32x2 v = {lo, hi}; bf16x2_t b = __builtin_convertvector(v, bf16x2_t); return __builtin_bit_cast(unsigned, b); }
__device__ __forceinline__ float bf_lo(unsigned w) { return __uint_as_float(w << 16); }
__device__ __forceinline__ float bf_hi(unsigned w) { return __uint_as_float(w & 0xffff0000u); }
constexpr float LOG2E = 1.4426950408889634f;
__device__ __forceinline__ float fast_sigmoid(float x) { return __builtin_amdgcn_rcpf(1.0f + __builtin_amdgcn_exp2f(-x * LOG2E)); }
__device__ __forceinline__ float silu_f(float x) { return x * fast_sigmoid(x); }
constexpr float RMS_EPS = 1e-6f;
__device__ __forceinline__ float row_rinv(const float* ssq, int row, int fq) {
    const f32x4 p = *(const f32x4*)(ssq + (size_t)row * 16 + 4 * fq);
    float s = (p[0] + p[1]) + (p[2] + p[3]);
    s += __shfl_xor(s, 16); s += __shfl_xor(s, 32);
    return __builtin_amdgcn_rsqf(s * (1.0f / 1024.0f) + RMS_EPS);
}

__device__ __forceinline__ void row_rinv8(float (&rs)[8], const float* ssq, int row0, int fq) {
    f32x4 pr[8];
#pragma unroll
    for (int q = 0; q < 8; ++q) pr[q] = *(const f32x4*)(ssq + (size_t)(row0 + (q >> 2) * HALF + (q & 3) * 16) * 16 + 4 * fq);
#pragma unroll
    for (int q = 0; q < 8; ++q) { float s = (pr[q][0] + pr[q][1]) + (pr[q][2] + pr[q][3]); s += __shfl_xor(s, 16); s += __shfl_xor(s, 32); rs[q] = __builtin_amdgcn_rsqf(s * (1.0f / 1024.0f) + RMS_EPS); }
}
struct EpiSwiGLU {
    static constexpr bool PERM = true, AFTER_DRAIN = false;
    bf16_t* H; int ldh; const float* ssq;
    __device__ __forceinline__ void operator()(const f32x4 (&acc)[2][2][4][2], const Unit& u, int wr, int wc, int fr, int fq) const {
        const int row0 = u.pm * BM + wr * 64 + fr, col0 = u.pn * HALF + wc * 32 + 8 * fq;
        float rsv[8]; row_rinv8(rsv, ssq, row0, fq);
#pragma unroll
        for (int ai = 0; ai < 2; ++ai)
#pragma unroll
            for (int m = 0; m < 4; ++m) { const int row = row0 + ai * HALF + m * 16; const float rs = rsv[ai * 4 + m];
                float o[8];
#pragma unroll
                for (int n = 0; n < 2; ++n)
#pragma unroll
                    for (int i = 0; i < 4; ++i) { const float g = acc[ai][0][m][n][i] * rs, up = acc[ai][1][m][n][i] * rs; o[4 * n + i] = silu_f(g) * up; }
                u32x4 w; w.x = cvt_pk_bf16(o[0], o[1]); w.y = cvt_pk_bf16(o[2], o[3]); w.z = cvt_pk_bf16(o[4], o[5]); w.w = cvt_pk_bf16(o[6], o[7]);
                *(u32x4*)(H + (size_t)row * ldh + col0) = w; }
    }
};

struct EpiResid {
    static constexpr bool PERM = true, AFTER_DRAIN = false;
    const float* bf; const bf16_t* bb; float* of; bf16_t* ob; float alpha; float* ssq;
    __device__ __forceinline__ void operator()(const f32x4 (&acc)[2][2][4][2], const Unit& u, int wr, int wc, int fr, int fq) const {
        const int row0 = u.pm * BM + wr * 64 + fr, col0 = u.pn * BM + wc * 32 + 8 * fq;
#pragma unroll
        for (int ai = 0; ai < 2; ++ai) {
            f32x4 bs[4][2][2];
            if (bf) {
#pragma unroll
                for (int m = 0; m < 4; ++m) { const size_t off = (size_t)(row0 + ai * HALF + m * 16) * 1024 + col0;
#pragma unroll
                    for (int bj = 0; bj < 2; ++bj)
#pragma unroll
                        for (int n = 0; n < 2; ++n) bs[m][bj][n] = *(const f32x4*)(bf + off + bj * HALF + n * 4); }
            } else {
                u32x4 bw[4][2];
#pragma unroll
                for (int m = 0; m < 4; ++m) { const size_t off = (size_t)(row0 + ai * HALF + m * 16) * 1024 + col0;
#pragma unroll
                    for (int bj = 0; bj < 2; ++bj) bw[m][bj] = *(const u32x4*)(bb + off + bj * HALF); }
#pragma unroll
                for (int m = 0; m < 4; ++m)
#pragma unroll
                    for (int bj = 0; bj < 2; ++bj) { bs[m][bj][0] = (f32x4){bf_lo(bw[m][bj][0]), bf_hi(bw[m][bj][0]), bf_lo(bw[m][bj][1]), bf_hi(bw[m][bj][1])};
                        bs[m][bj][1] = (f32x4){bf_lo(bw[m][bj][2]), bf_hi(bw[m][bj][2]), bf_lo(bw[m][bj][3]), bf_hi(bw[m][bj][3])}; }
            }
            asm volatile("" ::: "memory");
#pragma unroll
            for (int m = 0; m < 4; ++m) { const int row = row0 + ai * HALF + m * 16; const size_t off = (size_t)row * 1024 + col0; float ss = 0.f;
#pragma unroll
                for (int bj = 0; bj < 2; ++bj) { const f32x4 v0 = bs[m][bj][0] + acc[ai][bj][m][0] * alpha, v1 = bs[m][bj][1] + acc[ai][bj][m][1] * alpha;
                    ss += ((v0[0] * v0[0] + v0[1] * v0[1]) + (v0[2] * v0[2] + v0[3] * v0[3])) + ((v1[0] * v1[0] + v1[1] * v1[1]) + (v1[2] * v1[2] + v1[3] * v1[3]));
                    if (of) { *(f32x4*)(of + off + bj * HALF) = v0; *(f32x4*)(of + off + bj * HALF + 4) = v1; }
                    if (ob) { u32x4 w; w.x = cvt_pk_bf16(v0[0], v0[1]); w.y = cvt_pk_bf16(v0[2], v0[3]); w.z = cvt_pk_bf16(v1[0], v1[1]); w.w = cvt_pk_bf16(v1[2], v1[3]); *(u32x4*)(ob + off + bj * HALF) = w; } }
                if (ssq) { ss += __shfl_xor(ss, 16); ss += __shfl_xor(ss, 32); if (fq == 0) ssq[(size_t)row * 16 + 4 * u.pn + wc] = ss; } }
            asm volatile("" ::: "memory");
        }
    }
};

struct EpiGate {
    static constexpr bool PERM = true, AFTER_DRAIN = false;
    bf16_t* T; const bf16_t* gate; int goff; bool first;
    __device__ __forceinline__ void operator()(const f32x4 (&acc)[2][2][4][2], const Unit& u, int wr, int wc, int fr, int fq) const {
        const int row0 = u.pm * BM + wr * 64 + fr, col0 = u.pn * BM + wc * 32 + 8 * fq;
#pragma unroll
        for (int ai = 0; ai < 2; ++ai) {
            u32x4 gw[4][2], tw[4][2];
#pragma unroll
            for (int m = 0; m < 4; ++m)
#pragma unroll
                for (int bj = 0; bj < 2; ++bj) { const int row = row0 + ai * HALF + m * 16, c = col0 + bj * HALF;
                    gw[m][bj] = *(const u32x4*)(gate + (size_t)row * 2048 + goff + c);
                    tw[m][bj] = first ? (u32x4){0u, 0u, 0u, 0u} : *(const u32x4*)(T + (size_t)row * 1024 + c); }
            asm volatile("" ::: "memory");
#pragma unroll
            for (int m = 0; m < 4; ++m)
#pragma unroll
                for (int bj = 0; bj < 2; ++bj) { const int row = row0 + ai * HALF + m * 16, c = col0 + bj * HALF;
                    float o[8];
#pragma unroll
                    for (int q = 0; q < 4; ++q) { o[2 * q] = fast_sigmoid(bf_lo(gw[m][bj][q])) * acc[ai][bj][m][q >> 1][(2 * q) & 3] + bf_lo(tw[m][bj][q]); o[2 * q + 1] = fast_sigmoid(bf_hi(gw[m][bj][q])) * acc[ai][bj][m][q >> 1][(2 * q + 1) & 3] + bf_hi(tw[m][bj][q]); }
                    u32x4 w; w.x = cvt_pk_bf16(o[0], o[1]); w.y = cvt_pk_bf16(o[2], o[3]); w.z = cvt_pk_bf16(o[4], o[5]); w.w = cvt_pk_bf16(o[6], o[7]);
                    *(u32x4*)(T + (size_t)row * 1024 + c) = w; }
            asm volatile("" ::: "memory");
        }
    }
};

struct ProjOut { bf16_t *QA, *KC, *VC, *KS, *VS, *KW, *VW, *QB, *KB, *VB, *GM; float *GA, *LF; };
constexpr float QSCALE = 0.125f * LOG2E;
struct EpiProj {
    static constexpr bool PERM = true, AFTER_DRAIN = false;
    ProjOut P; const float* ssq; const float *nsa_q_gain, *nsa_k_gain, *fox_q_gain, *fox_k_gain, *b_forget;
    __device__ __forceinline__ void operator()(const f32x4 (&acc)[2][2][4][2], const Unit& u, int wr, int wc, int fr, int fq) const {
        const int row0 = u.pm * BM + wr * 64 + fr; const int pn = u.pn;
        if (pn == 19) {
            if (wc != 0) return;
            f32x4 bfv[2]; bfv[0] = *(const f32x4*)(b_forget); bfv[1] = *(const f32x4*)(b_forget + 4);
            float rsv[8]; row_rinv8(rsv, ssq, row0, fq);
#pragma unroll
            for (int ai = 0; ai < 2; ++ai)
#pragma unroll
                for (int m = 0; m < 4; ++m) { const int row = row0 + ai * HALF + m * 16; const float rs = rsv[ai * 4 + m];
#pragma unroll
                    for (int n = 0; n < 2; ++n) { const f32x4 v = acc[ai][0][m][n] * rs; f32x4 o;
                        if (fq < 3) {
#pragma unroll
                            for (int i = 0; i < 4; ++i) o[i] = 1.0f / (1.0f + __expf(-v[i]));
                            *(f32x4*)(P.GA + (size_t)row * 24 + 8 * fq + 4 * n) = o;
                        } else {
#pragma unroll
                            for (int i = 0; i < 4; ++i) { const float x = v[i] + bfv[n][i]; o[i] = fminf(x, 0.f) - log1pf(__expf(-fabsf(x))); }
                            *(f32x4*)(P.LF + (size_t)row * 8 + 4 * n) = o;
                        } } }
            return;
        }
        int kind = 0; const float* gain = nullptr; float mul = 1.f; bf16_t* dst = nullptr; int pitch = 128;
        if (pn < 2) { kind = 1; gain = nsa_q_gain; mul = QSCALE; dst = P.QA + 256 * pn + 64 * wc; pitch = 512; }
        else if (pn == 2) { dst = (wc < 2) ? P.KC + 64 * wc : P.VC + 64 * (wc - 2); }
        else if (pn == 3) { if (wc < 2) { kind = 1; gain = nsa_k_gain + 64; dst = P.KS + 64 * wc; } else dst = P.VS + 64 * (wc - 2); }
        else if (pn == 4) { if (wc < 2) { kind = 1; gain = nsa_k_gain + 128; dst = P.KW + 64 * wc; } else dst = P.VW + 64 * (wc - 2); }
        else if (pn < 7) { kind = 1; gain = fox_q_gain; mul = QSCALE; dst = P.QB + 256 * (pn - 5) + 64 * wc; pitch = 512; }
        else if (pn < 9) { kind = 1; gain = fox_k_gain; dst = P.KB + 256 * (pn - 7) + 64 * wc; pitch = 512; }
        else if (pn < 11) { dst = P.VB + 256 * (pn - 9) + 64 * wc; pitch = 512; }
        else { dst = P.GM + 256 * (pn - 11) + 64 * wc; pitch = 2048; }
        f32x4 gv[2][2];
#pragma unroll
        for (int bj = 0; bj < 2; ++bj)
#pragma unroll
            for (int n = 0; n < 2; ++n) { gv[bj][n] = (f32x4){1.f, 1.f, 1.f, 1.f}; if (kind == 1) gv[bj][n] = *(const f32x4*)(gain + 32 * bj + 8 * fq + 4 * n); }
        float rsv[8]; row_rinv8(rsv, ssq, row0, fq);
#pragma unroll
        for (int ai = 0; ai < 2; ++ai)
#pragma unroll
            for (int m = 0; m < 4; ++m) { const int row = row0 + ai * HALF + m * 16; const float rs = rsv[ai * 4 + m];
                float hs = rs;
                if (kind == 1) { float ss = 0.f;
#pragma unroll
                    for (int bj = 0; bj < 2; ++bj)
#pragma unroll
                        for (int n = 0; n < 2; ++n) { const f32x4 v = acc[ai][bj][m][n] * rs; ss += (v[0] * v[0] + v[1] * v[1]) + (v[2] * v[2] + v[3] * v[3]); }
                    ss += __shfl_xor(ss, 16); ss += __shfl_xor(ss, 32); hs = rs * __builtin_amdgcn_rsqf(ss * (1.0f / 64.0f) + RMS_EPS) * mul; }
#pragma unroll
                for (int bj = 0; bj < 2; ++bj) { float o[8];
#pragma unroll
                    for (int n = 0; n < 2; ++n) { const f32x4 gvn = gv[bj][n];
#pragma unroll
                        for (int i = 0; i < 4; ++i) o[4 * n + i] = acc[ai][bj][m][n][i] * hs * gvn[i]; }
                    u32x4 w; w.x = cvt_pk_bf16(o[0], o[1]); w.y = cvt_pk_bf16(o[2], o[3]); w.z = cvt_pk_bf16(o[4], o[5]); w.w = cvt_pk_bf16(o[6], o[7]);
                    *(u32x4*)(dst + (size_t)row * pitch + 32 * bj + 8 * fq) = w; } }
    }
};

template <class Epi, class Sched, bool ALIGN_EPI = false, bool SP2 = false>
__device__ __forceinline__ void gemm_phase(PG8_LAS unsigned char* lds, const Gemm g, const Sched& S, const Epi& E, int tid_in) {
    int tid_ = tid_in; asm volatile("" : "+v"(tid_));
    const int tid = tid_, wid = __builtin_amdgcn_readfirstlane(tid >> 6), lane = tid & 63, wr = wid >> 2, wc = wid & 3, fr = lane & 15, fq = lane >> 4;
    const int K = g.K, nt = K / BK;
    unsigned voffA[2], voffB[2];
#pragma unroll
    for (int i = 0; i < 2; ++i) { int R, C; stage_rc(tid * 16 + i * 8192, R, C); const int Rb = Epi::PERM ? ((R & ~31) + perm32(R & 31)) : R;
        voffA[i] = (unsigned)(R * K + C) * 2u; voffB[i] = (unsigned)(Rb * K + C) * 2u; }
    const size_t kstep = (size_t)(BK * 2);
    const size_t hstep = (size_t)HALF * K * 2;
    const size_t tstep = 2 * hstep;
    const unsigned ldsw = (unsigned)wid * 1024u;
    const int aoff = lds_byte(wr * 64 + fr, fq * 8), boff = lds_byte(wc * 32 + fr, fq * 8);
#define PG8_SA(b, h) (((b) * 2 + (h)) * HTB)
#define PG8_SB(b, h) ((4 + (b) * 2 + (h)) * HTB)
#define PG8_STAGE(bufoff, gbase, voff) do { _Pragma("unroll") for (int _i = 0; _i < 2; ++_i) \
        __builtin_amdgcn_global_load_lds((const unsigned*)((const char*)(gbase) + (voff)[_i]), (PG8_LAS unsigned*)(lds + (bufoff) + ldsw + _i * 8192), 16, 0, 0); } while (0)
#define PG8_LDA(dst, b, h) do { _Pragma("unroll") for (int m = 0; m < 4; ++m) _Pragma("unroll") for (int k = 0; k < 2; ++k) dst[m][k] = *(const PG8_LAS bf16x8*)(lds + PG8_SA(b, h) + aoff + m * 2048 + k * 1024); } while (0)
#define PG8_LDB(dst, b, h) do { _Pragma("unroll") for (int n = 0; n < 2; ++n) _Pragma("unroll") for (int k = 0; k < 2; ++k) dst[n][k] = *(const PG8_LAS bf16x8*)(lds + PG8_SB(b, h) + boff + n * 2048 + k * 1024); } while (0)
#define PG8_MMA(ai, bj, At, Bt) do { __builtin_amdgcn_s_setprio(1); _Pragma("unroll") for (int m = 0; m < 4; ++m) _Pragma("unroll") for (int n = 0; n < 2; ++n) _Pragma("unroll") for (int k = 0; k < 2; ++k) \
        acc[ai][bj][m][n] = __builtin_amdgcn_mfma_f32_16x16x32_bf16(Bt[n][k], At[m][k], acc[ai][bj][m][n], 0, 0, 0); __builtin_amdgcn_s_setprio(0); } while (0)
#define PG8_WAIT_V(n) asm volatile("s_waitcnt vmcnt(" #n ")" ::: "memory")
#define PG8_WAIT_L(n) asm volatile("s_waitcnt lgkmcnt(" #n ")" ::: "memory")
#define PG8_BAR __builtin_amdgcn_s_barrier()
#define PG8_SCHED __builtin_amdgcn_sched_barrier(0)
    Unit cur, nxt; int ui = 0;
    if (!S.next(0, cur)) return;
    f32x4 acc[2][2][4][2];
#pragma unroll
    for (int a = 0; a < 2; ++a)
#pragma unroll
        for (int b = 0; b < 2; ++b)
#pragma unroll
            for (int m = 0; m < 4; ++m)
#pragma unroll
                for (int n = 0; n < 2; ++n) acc[a][b][m][n] = (f32x4){0.f, 0.f, 0.f, 0.f};
    bf16x8 At[4][2], B0[2][2], B1[2][2];
    const char* cA = (const char*)g.A + (size_t)cur.pm * tstep; const char* cB = (const char*)g.Bt + (size_t)cur.pn * tstep;
    S.a_ready(cur);
    if constexpr (SP2) {
        PG8_STAGE(PG8_SB(0, 0), cB, voffB); PG8_STAGE(PG8_SB(0, 1), cB + hstep, voffB); PG8_STAGE(PG8_SA(0, 0), cA, voffA); PG8_STAGE(PG8_SA(0, 1), cA + hstep, voffA);
        if (wr == 1) PG8_BAR;
        PG8_WAIT_V(2); PG8_BAR;
        PG8_STAGE(PG8_SB(1, 0), cB + kstep, voffB); PG8_STAGE(PG8_SA(1, 0), cA + kstep, voffA); PG8_STAGE(PG8_SB(1, 1), cB + hstep + kstep, voffB);
        PG8_WAIT_V(6); PG8_BAR;
    } else {
        PG8_STAGE(PG8_SB(0, 0), cB, voffB); PG8_STAGE(PG8_SA(0, 0), cA, voffA); PG8_STAGE(PG8_SB(0, 1), cB + hstep, voffB); PG8_STAGE(PG8_SA(0, 1), cA + hstep, voffA);
        if (wr == 1) PG8_BAR;
        PG8_WAIT_V(4); PG8_BAR;
        PG8_STAGE(PG8_SB(1, 0), cB + kstep, voffB); PG8_STAGE(PG8_SA(1, 0), cA + kstep, voffA); PG8_STAGE(PG8_SB(1, 1), cB + hstep + kstep, voffB);
        PG8_WAIT_V(6); PG8_BAR;
    }
    for (;;) {
        const bool has_next = S.next(ui + 1, nxt);
        const char* nA = has_next ? (const char*)g.A + (size_t)nxt.pm * tstep : cA; const char* nB = has_next ? (const char*)g.Bt + (size_t)nxt.pn * tstep : cB;
        for (int t = 0; t < nt; t += 2) {
            const bool last = (t == nt - 2);
            const char* a1 = cA + (size_t)(t + 1) * kstep;
            const char* a2 = last ? nA : cA + (size_t)(t + 2) * kstep; const char* b2 = last ? nB : cB + (size_t)(t + 2) * kstep;
            const char* a3 = a2 + kstep; const char* b3 = b2 + kstep;
            if (last && has_next) S.a_ready(nxt);
            if constexpr (SP2) {
            PG8_LDB(B0, 0, 0); PG8_LDB(B1, 0, 1); PG8_SCHED; PG8_LDA(At, 0, 0); PG8_STAGE(PG8_SA(1, 1), a1 + hstep, voffA);
            PG8_WAIT_V(8); PG8_WAIT_L(0); PG8_BAR; PG8_MMA(0, 0, At, B0); PG8_MMA(0, 1, At, B1); PG8_BAR; PG8_SCHED;
            PG8_LDA(At, 0, 1); PG8_STAGE(PG8_SB(0, 0), b2, voffB); PG8_STAGE(PG8_SB(0, 1), b2 + hstep, voffB); PG8_STAGE(PG8_SA(0, 0), a2, voffA);
            PG8_WAIT_V(8); PG8_WAIT_L(0); PG8_BAR; PG8_MMA(1, 0, At, B0); PG8_MMA(1, 1, At, B1); PG8_BAR; PG8_SCHED;
            PG8_LDB(B0, 1, 0); PG8_LDB(B1, 1, 1); PG8_SCHED; PG8_LDA(At, 1, 0); PG8_STAGE(PG8_SA(0, 1), a2 + hstep, voffA);
            PG8_WAIT_V(8); PG8_WAIT_L(0); PG8_BAR; PG8_MMA(0, 0, At, B0); PG8_MMA(0, 1, At, B1); PG8_BAR; PG8_SCHED;
            PG8_LDA(At, 1, 1); PG8_STAGE(PG8_SB(1, 0), b3, voffB); PG8_STAGE(PG8_SB(1, 1), b3 + hstep, voffB); PG8_STAGE(PG8_SA(1, 0), a3, voffA);
            PG8_WAIT_V(8); PG8_WAIT_L(0); PG8_BAR; PG8_MMA(1, 0, At, B0); PG8_MMA(1, 1, At, B1); PG8_BAR; PG8_SCHED;
            } else {
            PG8_LDB(B0, 0, 0); PG8_SCHED; PG8_LDA(At, 0, 0); PG8_STAGE(PG8_SA(1, 1), a1 + hstep, voffA);
            PG8_WAIT_L(8); PG8_BAR; PG8_WAIT_L(0); PG8_MMA(0, 0, At, B0); PG8_BAR; PG8_SCHED;
            PG8_LDB(B1, 0, 1); PG8_STAGE(PG8_SB(0, 0), b2, voffB);
            PG8_BAR; PG8_WAIT_L(0); PG8_MMA(0, 1, At, B1); PG8_BAR;
            PG8_LDA(At, 0, 1); PG8_STAGE(PG8_SA(0, 0), a2, voffA);
            PG8_BAR; PG8_WAIT_L(0); PG8_MMA(1, 0, At, B0); PG8_BAR; PG8_SCHED;
            PG8_STAGE(PG8_SB(0, 1), b2 + hstep, voffB);
            PG8_WAIT_V(6); PG8_BAR; PG8_MMA(1, 1, At, B1); PG8_BAR;
            PG8_LDB(B0, 1, 0); PG8_SCHED; PG8_LDA(At, 1, 0); PG8_STAGE(PG8_SA(0, 1), a2 + hstep, voffA);
            PG8_WAIT_L(8); PG8_BAR; PG8_WAIT_L(0); PG8_MMA(0, 0, At, B0); PG8_BAR; PG8_SCHED;
            PG8_LDB(B1, 1, 1); PG8_STAGE(PG8_SB(1, 0), b3, voffB);
            PG8_BAR; PG8_WAIT_L(0); PG8_MMA(0, 1, At, B1); PG8_BAR;
            PG8_LDA(At, 1, 1); PG8_STAGE(PG8_SA(1, 0), a3, voffA);
            PG8_BAR; PG8_WAIT_L(0); PG8_MMA(1, 0, At, B0); PG8_BAR; PG8_SCHED;
            PG8_STAGE(PG8_SB(1, 1), b3 + hstep, voffB);
            PG8_WAIT_V(6); PG8_BAR; PG8_MMA(1, 1, At, B1); PG8_BAR;
            }
        }
        if constexpr (ALIGN_EPI) { if (wr == 0) PG8_BAR; }
        if constexpr (!Epi::AFTER_DRAIN) { E(acc, cur, wr, wc, fr, fq); S.done(cur); }
        if (!has_next) break;
#pragma unroll
        for (int a = 0; a < 2; ++a)
#pragma unroll
            for (int b = 0; b < 2; ++b)
#pragma unroll
                for (int m = 0; m < 4; ++m)
#pragma unroll
                    for (int n = 0; n < 2; ++n) acc[a][b][m][n] = (f32x4){0.f, 0.f, 0.f, 0.f};
        cur = nxt; cA = nA; cB = nB; ++ui;
        if constexpr (ALIGN_EPI) { if (wr == 1) PG8_BAR; }
    }
    PG8_WAIT_V(0);
    if constexpr (!ALIGN_EPI) { if (wr == 0) PG8_BAR; }
    PG8_BAR;
    if constexpr (Epi::AFTER_DRAIN) { E.fused(acc, cur, wr, wc, fr, fq, lds, wid, lane); S.done(cur); }
#undef PG8_SA
#undef PG8_SB
#undef PG8_STAGE
#undef PG8_LDA
#undef PG8_LDB
#undef PG8_MMA
#undef PG8_WAIT_V
#undef PG8_WAIT_L
#undef PG8_BAR
#undef PG8_SCHED
}
}

constexpr int BATCH = 16, SEQ = 2048, DM = 1024, MTOK = BATCH * SEQ, DFF = 2816, NUP = 2 * DFF, D_IN = 4896, NIN = 5120;
constexpr int NWAVES = 8, NTHREADS = 512;
#define LAS __attribute__((address_space(3)))
typedef pg8::bf16_t bf16_t;
typedef short bf16x8 __attribute__((ext_vector_type(8)));
typedef float f32x4 __attribute__((ext_vector_type(4)));
typedef float f32x16 __attribute__((ext_vector_type(16)));
typedef unsigned u32x4 __attribute__((ext_vector_type(4)));
typedef unsigned u32x2 __attribute__((ext_vector_type(2)));
typedef short s16x4 __attribute__((ext_vector_type(4)));
using pg8::cvt_pk_bf16; using pg8::LOG2E; using pg8::RMS_EPS;

constexpr size_t MiB = 1u << 20, KiB = 1u << 10;
constexpr size_t WS_WUP1 = 1 * MiB, WS_WDN1 = 12 * MiB, WS_WIN = 18 * MiB, WS_WON = 28 * MiB, WS_WOF = 29 * MiB, WS_WOUT = 30 * MiB, WS_WUP2 = 32 * MiB, WS_WDN2 = 43 * MiB;
constexpr size_t WS_CW1K = 49 * MiB, WS_CW1V = 49 * MiB + 512 * KiB, WS_CW2K = 50 * MiB, WS_CW2V = 50 * MiB + 64 * KiB, WS_TAB = 50 * MiB + 128 * KiB, WS_C1 = 50 * MiB + 192 * KiB;
constexpr size_t WS_KCMP = 51 * MiB, WS_VCMP = 51 * MiB + 512 * KiB, WS_SSQ = 52 * MiB, WS_GA = 54 * MiB, WS_LF = 57 * MiB;
constexpr size_t WS_XB = 58 * MiB;
constexpr size_t WS_A = 122 * MiB;
constexpr size_t A_QA = 0, A_KC = 32 * MiB, A_VC = 40 * MiB, A_KS = 48 * MiB, A_VS = 56 * MiB, A_KW = 64 * MiB, A_VW = 72 * MiB, A_QB = 80 * MiB, A_KB = 112 * MiB, A_VB = 144 * MiB, A_GM = 176 * MiB;
constexpr size_t WS_END = 426 * MiB;
constexpr int LDS_BYTES = 147456;

__constant__ unsigned char T5_BUCKET[128] = {0, 1, 2, 3, 4, 5, 6, 7, 8, 9, 10, 11, 12, 13, 14, 15, 16, 16, 16, 17, 17, 18, 18, 18, 19, 19, 19, 20, 20, 20, 20, 21, 21, 21, 21, 22, 22, 22, 22, 22, 23, 23, 23, 23, 23, 23, 24, 24, 24, 24, 24, 24, 25, 25, 25, 25, 25, 25, 25, 26, 26, 26, 26, 26, 26, 26, 26, 27, 27, 27, 27, 27, 27, 27, 27, 27, 27, 28, 28, 28, 28, 28, 28, 28, 28, 28, 28, 29, 29, 29, 29, 29, 29, 29, 29, 29, 29, 29, 29, 30, 30, 30, 30, 30, 30, 30, 30, 30, 30, 30, 30, 30, 30, 31, 31, 31, 31, 31, 31, 31, 31, 31, 31, 31, 31, 31, 31, 31};

struct Args { const float* in[24]; float* out; unsigned char* ws; int ph_lo, ph_hi; };

#define LDS_WAIT() asm volatile("s_waitcnt lgkmcnt(0)" ::: "memory")
__device__ __forceinline__ float wave_sum(float v) {
#pragma unroll
    for (int o = 1; o < 64; o <<= 1) v += __shfl_xor(v, o);
    return v;
}

template <int MODE> __device__ __forceinline__ int src_col(int n) {
    if (MODE == 0) return n;
    if (MODE == 1) { const int pn = n >> 8, bj = (n >> 7) & 1, q = n & 127; return bj * DFF + 128 * pn + q; }
    const int pn = n >> 8, bj = (n >> 7) & 1, wc = (n >> 5) & 3, j = n & 31, L = 256 * pn + 64 * wc + 32 * bj + j;
    if (L < 1280) return L;
    if (L < 2816) return 1304 + (L - 1280);
    if (L < 4864) return 2848 + (L - 2816);
    if (L < 4888) return 1280 + (L - 4864);
    if (L < 4896) return 2840 + (L - 4888);
    return -1;
}
template <int MODE> __device__ __forceinline__ void transpose_item(const float* W, int ldw, int K, int N, const float* ks, bf16_t* WT, LAS float* scr, int item, int lane) {
    const int nblk = N / 32, kb = item / nblk, nb = item % nblk, k0 = 64 * kb, n0 = 32 * nb;
    const int sc = src_col<MODE>(n0 + (lane & 31));
#pragma unroll
    for (int i0 = 0; i0 < 32; i0 += 16) { float v[16];
#pragma unroll
        for (int i = 0; i < 16; ++i) { const int kk = 2 * (i0 + i) + (lane >> 5); v[i] = (sc >= 0) ? W[(size_t)(k0 + kk) * ldw + sc] : 0.f; }
#pragma unroll
        for (int i = 0; i < 16; ++i) { const int kk = 2 * (i0 + i) + (lane >> 5); float x = v[i]; if (ks) x *= ks[k0 + kk]; scr[kk * 33 + (lane & 31)] = x; } }
    LDS_WAIT(); asm volatile("" ::: "memory");
    const int c = lane & 7;
#pragma unroll
    for (int j = 0; j < 4; ++j) { const int n = (lane >> 3) + 8 * j; const LAS float* s = scr + (8 * c) * 33 + n;
        u32x4 o; o.x = cvt_pk_bf16(s[0 * 33], s[1 * 33]); o.y = cvt_pk_bf16(s[2 * 33], s[3 * 33]); o.z = cvt_pk_bf16(s[4 * 33], s[5 * 33]); o.w = cvt_pk_bf16(s[6 * 33], s[7 * 33]);
        *(u32x4*)(WT + (size_t)(n0 + n) * K + k0 + 8 * c) = o; }
    LDS_WAIT(); asm volatile("" ::: "memory");
}

__device__ __forceinline__ void prep_phase(const Args& a, LAS unsigned char* lds, int vcu, int G, int wave, int lane) {
    unsigned char* ws = a.ws;
    LAS float* scr = (LAS float*)(lds + wave * 16384);
    const int gw = vcu * NWAVES + wave, NGW = G * NWAVES;
    constexpr int I_UP = (DM / 64) * (NUP / 32), I_DN = (DFF / 64) * (DM / 32), I_IN = (DM / 64) * (NIN / 32), I_O = (512 / 64) * (DM / 32), I_OUT = (DM / 64) * (DM / 32), I_C1 = (2048 / 64) * (128 / 32), I_C2 = (128 / 64) * (64 / 32);
    constexpr int NITEMS = 2 * I_UP + 2 * I_DN + I_IN + 2 * I_O + I_OUT + 2 * I_C1 + 2 * I_C2;
    for (int it = gw; it < NITEMS; it += NGW) {
        int r = it;
        if (r < I_UP) { transpose_item<1>(a.in[2], NUP, DM, NUP, a.in[1], (bf16_t*)(ws + WS_WUP1), scr, r, lane); continue; } r -= I_UP;
        if (r < I_UP) { transpose_item<1>(a.in[21], NUP, DM, NUP, a.in[20], (bf16_t*)(ws + WS_WUP2), scr, r, lane); continue; } r -= I_UP;
        if (r < I_DN) { transpose_item<0>(a.in[3], DM, DFF, DM, nullptr, (bf16_t*)(ws + WS_WDN1), scr, r, lane); continue; } r -= I_DN;
        if (r < I_DN) { transpose_item<0>(a.in[22], DM, DFF, DM, nullptr, (bf16_t*)(ws + WS_WDN2), scr, r, lane); continue; } r -= I_DN;
        if (r < I_IN) { transpose_item<2>(a.in[5], D_IN, DM, NIN, a.in[4], (bf16_t*)(ws + WS_WIN), scr, r, lane); continue; } r -= I_IN;
        if (r < I_O) { transpose_item<0>(a.in[17], DM, 512, DM, nullptr, (bf16_t*)(ws + WS_WON), scr, r, lane); continue; } r -= I_O;
        if (r < I_O) { transpose_item<0>(a.in[18], DM, 512, DM, nullptr, (bf16_t*)(ws + WS_WOF), scr, r, lane); continue; } r -= I_O;
        if (r < I_OUT) { transpose_item<0>(a.in[19], DM, DM, DM, nullptr, (bf16_t*)(ws + WS_WOUT), scr, r, lane); continue; } r -= I_OUT;
        if (r < I_C1) { transpose_item<0>(a.in[13], 128, 2048, 128, nullptr, (bf16_t*)(ws + WS_CW1K), scr, r, lane); continue; } r -= I_C1;
        if (r < I_C1) { transpose_item<0>(a.in[15], 128, 2048, 128, nullptr, (bf16_t*)(ws + WS_CW1V), scr, r, lane); continue; } r -= I_C1;
        if (r < I_C2) { transpose_item<0>(a.in[14], 64, 128, 64, nullptr, (bf16_t*)(ws + WS_CW2K), scr, r, lane); continue; } r -= I_C2;
        transpose_item<0>(a.in[16], 64, 128, 64, nullptr, (bf16_t*)(ws + WS_CW2V), scr, r, lane);
    }
    const float* x = a.in[0]; bf16_t* XB = (bf16_t*)(ws + WS_XB); float* SSQ = (float*)(ws + WS_SSQ);
    for (int m = gw; m < MTOK; m += 2 * NGW) {
        const int m2 = m + NGW;
        const f32x4* xr = (const f32x4*)(x + (size_t)m * DM) + lane; const f32x4* xr2 = (const f32x4*)(x + (size_t)(m2 < MTOK ? m2 : m) * DM) + lane; f32x4 v[4], w2[4]; float s = 0.f, s2 = 0.f;
#pragma unroll
        for (int j = 0; j < 4; ++j) { v[j] = xr[64 * j]; w2[j] = xr2[64 * j]; }
#pragma unroll
        for (int j = 0; j < 4; ++j) { s += (v[j][0] * v[j][0] + v[j][1] * v[j][1]) + (v[j][2] * v[j][2] + v[j][3] * v[j][3]); s2 += (w2[j][0] * w2[j][0] + w2[j][1] * w2[j][1]) + (w2[j][2] * w2[j][2] + w2[j][3] * w2[j][3]); }
        s = wave_sum(s); s2 = wave_sum(s2);
        u32x2* o8 = (u32x2*)(XB + (size_t)m * DM) + lane;
#pragma unroll
        for (int j = 0; j < 4; ++j) { u32x2 w; w.x = cvt_pk_bf16(v[j][0], v[j][1]); w.y = cvt_pk_bf16(v[j][2], v[j][3]); o8[64 * j] = w; }
        if (lane < 16) SSQ[(size_t)m * 16 + lane] = (lane == 0) ? s : 0.f;
        if (m2 < MTOK) { u32x2* o82 = (u32x2*)(XB + (size_t)m2 * DM) + lane;
#pragma unroll
            for (int j = 0; j < 4; ++j) { u32x2 w; w.x = cvt_pk_bf16(w2[j][0], w2[j][1]); w.y = cvt_pk_bf16(w2[j][2], w2[j][3]); o82[64 * j] = w; }
            if (lane < 16) SSQ[(size_t)m2 * 16 + lane] = (lane == 0) ? s2 : 0.f; }
    }
    { float* TAB = (float*)(ws + WS_TAB); const float* tbl = a.in[23];
      for (int i = gw * 64 + lane; i < 8 * 128; i += NGW * 64) { const int h = i >> 7, d = i & 127; TAB[i] = tbl[(int)T5_BUCKET[d] * 8 + h] * LOG2E; } }
    { float* C1 = (float*)(ws + WS_C1);
      for (int o = gw; o < 256; o += NGW) { const int kv = o >> 7, n = o & 127; const float* pos = a.in[11 + kv]; const float* w1 = a.in[13 + 2 * kv]; float s = 0.f;
          for (int k = lane; k < 2048; k += 64) s += pos[k] * w1[(size_t)k * 128 + n];
          s = wave_sum(s); if (lane == 0) C1[o] = s; } }
}

constexpr int KVP = 144, KVT = 64 * KVP;
constexpr float NEG = -1.0e30f;
__device__ __forceinline__ int crow(int r, int h) { return (r & 3) + 8 * (r >> 2) + 4 * h; }
#define MFMA32(a, b, c) __builtin_amdgcn_mfma_f32_32x32x16_bf16((a), (b), (c), 0, 0, 0)
typedef short v4i16_t __attribute__((ext_vector_type(4)));
__device__ __forceinline__ s16x4 vtr(LAS const unsigned char* p) { return __builtin_bit_cast(s16x4, __builtin_amdgcn_ds_read_tr16_b64_v4i16((LAS v4i16_t*)p)); }

__device__ __forceinline__ void qk_tile(f32x16& p0, f32x16& p1, LAS const unsigned char* Kt, const bf16x8 (&qf)[4], int lane) {
    LAS const unsigned char* kp = Kt + (lane & 31) * KVP + 16 * (lane >> 5);
    f32x16 z = {}; p0 = z; p1 = z;
#pragma unroll
    for (int s = 0; s < 4; ++s) { const bf16x8 a0 = *(LAS const bf16x8*)(kp + 32 * s), a1 = *(LAS const bf16x8*)(kp + 32 * KVP + 32 * s);
        p0 = MFMA32(a0, qf[s], p0); p1 = MFMA32(a1, qf[s], p1); }
}
__device__ __forceinline__ void pv_tile(f32x16& o0, f32x16& o1, LAS const unsigned char* Vt, const bf16x8 (&pf)[4], int lane) {
    const int q = (lane & 15) >> 2, swz = ((q >> 1) & 1) * 64;
    LAS const unsigned char* vp0 = Vt + (4 * (lane >> 5) + q) * 128 + (((16 * ((lane >> 4) & 1) + 4 * (lane & 3)) * 2) ^ swz);
    LAS const unsigned char* vp1 = Vt + (4 * (lane >> 5) + q) * 128 + (((16 * ((lane >> 4) & 1) + 4 * (lane & 3)) * 2 + 64) ^ swz);
#pragma unroll
    for (int s = 0; s < 4; ++s) {
        const s16x4 l0 = vtr(vp0 + (16 * s) * 128), h0 = vtr(vp0 + (16 * s + 8) * 128), l1 = vtr(vp1 + (16 * s) * 128), h1 = vtr(vp1 + (16 * s + 8) * 128);
        const bf16x8 v0 = {l0[0], l0[1], l0[2], l0[3], h0[0], h0[1], h0[2], h0[3]}, v1 = {l1[0], l1[1], l1[2], l1[3], h1[0], h1[1], h1[2], h1[3]};
        o0 = MFMA32(v0, pf[s], o0); o1 = MFMA32(v1, pf[s], o1); }
}
__device__ __forceinline__ void pack_p(bf16x8 (&pf)[4], const f32x16& p0, const f32x16& p1) {
#pragma unroll
    for (int s = 0; s < 4; ++s) { const f32x16& p = (s < 2) ? p0 : p1; const int b = 8 * (s & 1);
        u32x4 w; w.x = cvt_pk_bf16(p[b], p[b + 1]); w.y = cvt_pk_bf16(p[b + 2], p[b + 3]); w.z = cvt_pk_bf16(p[b + 4], p[b + 5]); w.w = cvt_pk_bf16(p[b + 6], p[b + 7]);
        pf[s] = __builtin_bit_cast(bf16x8, w); }
}
struct FState { f32x16 o0, o1; float m, l; };
__device__ __forceinline__ void fstate_init(FState& st) { f32x16 z = {}; st.o0 = z; st.o1 = z; st.m = NEG; st.l = 0.f; }
#define MX3(a, b, c) __builtin_fmaxf(__builtin_fmaxf((a), (b)), (c))
__device__ __forceinline__ void softmax_pv(FState& st, f32x16& p0, f32x16& p1, LAS const unsigned char* Vt, int lane) {
    float a = MX3(p0[0], p0[1], p1[0]), b = MX3(p0[2], p0[3], p1[1]); a = MX3(a, p1[2], p1[3]);
#pragma unroll
    for (int r = 4; r < 16; r += 4) { a = MX3(a, p0[r], p0[r + 1]); b = MX3(b, p0[r + 2], p0[r + 3]); a = MX3(a, p1[r], p1[r + 1]); b = MX3(b, p1[r + 2], p1[r + 3]); }
    float mx = __builtin_fmaxf(a, b);
    mx = __builtin_fmaxf(mx, __shfl_xor(mx, 32));
    if (__any(mx > st.m + 8.0f)) {
        const float mn = (mx > st.m + 8.0f) ? mx : st.m, alpha = __builtin_amdgcn_exp2f(st.m - mn);
        st.l *= alpha; st.o0 *= alpha; st.o1 *= alpha; st.m = mn;
    }
    const float m = st.m; float s0 = 0.f, s1 = 0.f;
#pragma unroll
    for (int r = 0; r < 16; ++r) { p0[r] = __builtin_amdgcn_exp2f(p0[r] - m); p1[r] = __builtin_amdgcn_exp2f(p1[r] - m); s0 += p0[r]; s1 += p1[r]; }
    st.l += s0 + s1;
    bf16x8 pf[4]; pack_p(pf, p0, p1);
    pv_tile(st.o0, st.o1, Vt, pf, lane);
}
__device__ __forceinline__ u32x4 tile_ld(const bf16_t* base, int pitch, int tid) { return *(const u32x4*)(base + (size_t)(tid >> 3) * pitch + (tid & 7) * 8); }
__device__ __forceinline__ void tile_st(LAS unsigned char* T, u32x4 v, int tid) { *(LAS u32x4*)(T + (tid >> 3) * KVP + (tid & 7) * 16) = v; }
__device__ __forceinline__ void tile_st_v(LAS unsigned char* T, u32x4 v, int tid) { const int row = tid >> 3; *(LAS u32x4*)(T + row * 128 + (((tid & 7) * 16) ^ (((row >> 1) & 1) * 64))) = v; }

template <int MODE> __device__ __forceinline__ int pop_tile(unsigned& tiles) { int j; if (MODE == 2) { j = 31 - __builtin_clz(tiles); tiles &= ~(1u << j); } else { j = __builtin_ctz(tiles); tiles &= tiles - 1u; } return j; }
template <int MODE> __device__ __forceinline__ void flash_loop(FState& st, unsigned tiles, const bf16_t* Kg, const bf16_t* Vg, int pitch, LAS unsigned char* kvb, const bf16x8 (&qf)[4],
                                                               LAS const float* aux, int t, int R0, unsigned selbits, int tq, int tid, int lane) {
    if (tiles == 0u) return;
    const int h = lane >> 5;
    int cur = 0;
    int j0 = pop_tile<MODE>(tiles), j1 = tiles ? pop_tile<MODE>(tiles) : -1;
    { const u32x4 k = tile_ld(Kg + (size_t)(64 * j0) * pitch, pitch, tid), v = tile_ld(Vg + (size_t)(64 * j0) * pitch, pitch, tid);
      tile_st(kvb, k, tid); tile_st_v(kvb + KVT, v, tid); }
    u32x4 k1 = {}, v1 = {};
    if (j1 >= 0) { k1 = tile_ld(Kg + (size_t)(64 * j1) * pitch, pitch, tid); v1 = tile_ld(Vg + (size_t)(64 * j1) * pitch, pitch, tid); }
    __syncthreads();
    for (;;) {
        const int j = j0, j2 = tiles ? pop_tile<MODE>(tiles) : -1;
        u32x4 k2 = {}, v2 = {};
        if (j2 >= 0) { k2 = tile_ld(Kg + (size_t)(64 * j2) * pitch, pitch, tid); v2 = tile_ld(Vg + (size_t)(64 * j2) * pitch, pitch, tid); }
        LAS unsigned char* Kt = kvb + cur * 2 * KVT; LAS unsigned char* Vt = Kt + KVT;
        const bool act = (MODE == 0) ? (64 * j <= R0 + 31) : true;
        if (act) {
            f32x16 p0, p1; qk_tile(p0, p1, Kt, qf, lane);
            const int kb = 64 * j + 4 * h;
            if (MODE == 0) {
#pragma unroll
                for (int g4 = 0; g4 < 4; ++g4) { const f32x4 c0 = *(LAS const f32x4*)(aux + kb + 8 * g4), c1 = *(LAS const f32x4*)(aux + kb + 8 * g4 + 32);
#pragma unroll
                    for (int i = 0; i < 4; ++i) { p0[4 * g4 + i] += c0[i]; p1[4 * g4 + i] += c1[i]; } }
                if (64 * j + 63 > R0) {
#pragma unroll
                    for (int r = 0; r < 16; ++r) { const int kp = kb + (r & 3) + 8 * (r >> 2); if (kp > t) p0[r] = NEG; if (kp + 32 > t) p1[r] = NEG; } }
            } else {
                const bool sel = (MODE == 2) || ((selbits >> j) & 1u);
                if (j + 3 <= tq) { const float c31 = sel ? aux[127 + 64] : NEG;
#pragma unroll
                    for (int r = 0; r < 16; ++r) { p0[r] += c31; p1[r] += c31; }
                } else { LAS const float* ab = aux + (t - kb + 1);
#pragma unroll
                    for (int r = 0; r < 16; ++r) { p0[r] += ab[63 - ((r & 3) + 8 * (r >> 2))]; p1[r] += ab[31 - ((r & 3) + 8 * (r >> 2))]; }
                    if (MODE == 1 && !sel) {
#pragma unroll
                        for (int r = 0; r < 16; ++r) { p0[r] = NEG; p1[r] = NEG; } }
                }
                if (MODE == 1) {
                    if (j == tq) {
#pragma unroll
                        for (int r = 0; r < 16; ++r) { const int kp = kb + (r & 3) + 8 * (r >> 2); if (kp > t) p0[r] = NEG; if (kp + 32 > t) p1[r] = NEG; } }
                } else {
                    if (j == tq || j + 8 == tq) {
#pragma unroll
                        for (int r = 0; r < 16; ++r) { const int d0 = t - (kb + (r & 3) + 8 * (r >> 2)), d1 = d0 - 32; if (d0 < 0 || d0 >= 512) p0[r] = NEG; if (d1 < 0 || d1 >= 512) p1[r] = NEG; } }
                }
            }
            softmax_pv(st, p0, p1, Vt, lane);
        }
        if (j1 >= 0) { LAS unsigned char* Kn = kvb + (cur ^ 1) * 2 * KVT; tile_st(Kn, k1, tid); tile_st_v(Kn + KVT, v1, tid); }
        __syncthreads();
        if (j1 < 0) break;
        j0 = j1; j1 = j2; k1 = k2; v1 = v2; cur ^= 1;
    }
}
__device__ __forceinline__ void store_ot(bf16_t* orow, const f32x16& o0, const f32x16& o1, int h) {
#pragma unroll
    for (int g4 = 0; g4 < 4; ++g4) { u32x2 w0, w1; w0.x = cvt_pk_bf16(o0[4 * g4], o0[4 * g4 + 1]); w0.y = cvt_pk_bf16(o0[4 * g4 + 2], o0[4 * g4 + 3]); w1.x = cvt_pk_bf16(o1[4 * g4], o1[4 * g4 + 1]); w1.y = cvt_pk_bf16(o1[4 * g4 + 2], o1[4 * g4 + 3]);
        *(u32x2*)(orow + 8 * g4 + 4 * h) = w0; *(u32x2*)(orow + 32 + 8 * g4 + 4 * h) = w1; }
}

__device__ __forceinline__ void compress_unit(int U, const Args& a, LAS unsigned char* lds, int tid, int wave, int lane) {
    unsigned char* ws = a.ws;
    const int kv = U & 1, ct = (U >> 1) & 3, g = (U >> 3) & 1, b = U >> 4;
    const bf16_t* SRC = (const bf16_t*)(ws + WS_A + (kv ? A_VC : A_KC));
    const bf16_t* W1T = (const bf16_t*)(ws + (kv ? WS_CW1V : WS_CW1K));
    const bf16_t* W2T = (const bf16_t*)(ws + (kv ? WS_CW2V : WS_CW2K));
    const float* C1 = (const float*)(ws + WS_C1) + 128 * kv;
    bf16_t* DST = (bf16_t*)(ws + (kv ? WS_VCMP : WS_KCMP)) + (size_t)((b * 2 + g) * 128 + 32 * ct) * 64;
    LAS float* hid = (LAS float*)lds;
    LAS unsigned char* hb = lds + 16640;
    LAS float* out2 = (LAS float*)(lds + 16640 + 8704);
    const int nt = wave & 3, kh = wave >> 2, i = lane & 31, h = lane >> 5;
    const int c = min(32 * ct + i, 126);
    const bf16_t* arow = SRC + (size_t)(b * SEQ + 16 * c + 16 * kh) * 128 + 64 * g + 8 * h;
    const bf16_t* brow = W1T + (size_t)(32 * nt + i) * 2048 + (16 * kh) * 64 + 8 * h;
    f32x16 acc = {};
#pragma unroll 4
    for (int lt = 0; lt < 16; ++lt)
#pragma unroll
        for (int s = 0; s < 4; ++s) { const bf16x8 av = *(const bf16x8*)(arow + lt * 128 + 16 * s), bv = *(const bf16x8*)(brow + lt * 64 + 16 * s); acc = MFMA32(av, bv, acc); }
    if (kh == 1) {
#pragma unroll
        for (int r = 0; r < 16; ++r) hid[crow(r, h) * 129 + 32 * nt + i] = acc[r];
    }
    __syncthreads();
    if (kh == 0) { const float c1 = C1[32 * nt + i];
#pragma unroll
        for (int r = 0; r < 16; ++r) { const float v = acc[r] + hid[crow(r, h) * 129 + 32 * nt + i] + c1; const float sv = pg8::silu_f(v);
            *(LAS bf16_t*)(hb + crow(r, h) * 272 + (32 * nt + i) * 2) = (bf16_t)(cvt_pk_bf16(sv, 0.f) & 0xffffu); }
    }
    __syncthreads();
    if (wave < 2) { f32x16 a2 = {};
#pragma unroll
        for (int s = 0; s < 8; ++s) { const bf16x8 av = *(LAS const bf16x8*)(hb + i * 272 + (16 * s + 8 * h) * 2), bv = *(const bf16x8*)(W2T + (size_t)(32 * wave + i) * 128 + 16 * s + 8 * h); a2 = MFMA32(av, bv, a2); }
#pragma unroll
        for (int r = 0; r < 16; ++r) out2[crow(r, h) * 65 + 32 * wave + i] = a2[r];
    }
    __syncthreads();
    { const int cl = tid >> 4, e4 = (tid & 15) * 4; float v[4]; float ss = 0.f;
#pragma unroll
      for (int q = 0; q < 4; ++q) { v[q] = out2[cl * 65 + e4 + q]; ss += v[q] * v[q]; }
      if (kv == 0) { ss += __shfl_xor(ss, 1); ss += __shfl_xor(ss, 2); ss += __shfl_xor(ss, 4); ss += __shfl_xor(ss, 8);
          const float rs = __builtin_amdgcn_rsqf(ss * (1.0f / 64.0f) + RMS_EPS); const float* gn = a.in[8];
#pragma unroll
          for (int q = 0; q < 4; ++q) v[q] = v[q] * rs * gn[e4 + q]; }
      if (32 * ct + cl >= 127) { v[0] = 0.f; v[1] = 0.f; v[2] = 0.f; v[3] = 0.f; }
      u32x2 w; w.x = cvt_pk_bf16(v[0], v[1]); w.y = cvt_pk_bf16(v[2], v[3]); *(u32x2*)(DST + (size_t)cl * 64 + e4) = w; }
    __syncthreads();
}

__device__ __forceinline__ void fox_unit(int b, int hh, int qb, const Args& a, LAS unsigned char* lds, int tid, int wave, int lane) {
    unsigned char* ws = a.ws;
    const bf16_t* QB = (const bf16_t*)(ws + WS_A + A_QB); const bf16_t* KB = (const bf16_t*)(ws + WS_A + A_KB); const bf16_t* VB = (const bf16_t*)(ws + WS_A + A_VB);
    const float* LF = (const float*)(ws + WS_LF); bf16_t* OF = (bf16_t*)(ws + WS_A + A_QB);
    LAS float* cum2 = (LAS float*)(lds + 4 * KVT); LAS float* wsum = (LAS float*)(lds + 4 * KVT + 8192);
    const int nrows = 256 * (qb + 1), h = lane >> 5;
    { float v[4];
#pragma unroll
      for (int i = 0; i < 4; ++i) { const int s = 4 * tid + i; v[i] = (s < nrows) ? LF[(size_t)(b * SEQ + s) * 8 + hh] : 0.f; }
      v[1] += v[0]; v[2] += v[1]; v[3] += v[2];
      float tot = v[3];
#pragma unroll
      for (int off = 1; off < 64; off <<= 1) { const float tt = __shfl_up(tot, off); if (lane >= off) tot += tt; }
      if (lane == 63) wsum[wave] = tot;
      __syncthreads();
      float base = 0.f;
      for (int i = 0; i < wave; ++i) base += wsum[i];
      const float excl = (tot - v[3]) + base;
#pragma unroll
      for (int i = 0; i < 4; ++i) cum2[4 * tid + i] = (v[i] + excl) * (-LOG2E);
      __syncthreads(); }
    const int R0 = 256 * qb + 32 * wave, t = R0 + (lane & 31); const size_t row = (size_t)b * SEQ + t;
    bf16x8 qf[4];
#pragma unroll
    for (int s = 0; s < 4; ++s) qf[s] = *(const bf16x8*)(QB + row * 512 + hh * 64 + 16 * s + 8 * h);
#pragma unroll
    for (int s = 0; s < 4; ++s) asm volatile("" : "+v"(qf[s]));
    FState st; fstate_init(st);
    const unsigned tiles = (qb == 7) ? 0xffffffffu : ((1u << (4 * qb + 4)) - 1u);
    flash_loop<0>(st, tiles, KB + (size_t)b * SEQ * 512 + hh * 64, VB + (size_t)b * SEQ * 512 + hh * 64, 512, lds, qf, cum2, t, R0, 0u, 0, tid, lane);
    float l = st.l + __shfl_xor(st.l, 32); const float inv = (l > 0.f) ? 1.0f / l : 0.f;
    st.o0 *= inv; st.o1 *= inv;
    store_ot(OF + row * 512 + hh * 64, st.o0, st.o1, h);
    __syncthreads();
}

constexpr int NL_CMP = 4 * KVT, NL_IMP = 8 * KVT, NL_SEL = NL_IMP + 4 * 64 * 33 * 4, NL_UNI = NL_SEL + 256, NL_TAB = NL_SEL + 512;
__device__ __forceinline__ void nsa_unit(int b, int g, int tq, const Args& a, LAS unsigned char* lds, int tid, int wave, int lane) {
    unsigned char* ws = a.ws;
    const bf16_t* QA = (const bf16_t*)(ws + WS_A + A_QA);
    const bf16_t* KS = (const bf16_t*)(ws + WS_A + A_KS); const bf16_t* VS = (const bf16_t*)(ws + WS_A + A_VS);
    const bf16_t* KW = (const bf16_t*)(ws + WS_A + A_KW); const bf16_t* VW = (const bf16_t*)(ws + WS_A + A_VW);
    const bf16_t* KCM = (const bf16_t*)(ws + WS_KCMP) + (size_t)(b * 2 + g) * 128 * 64; const bf16_t* VCM = (const bf16_t*)(ws + WS_VCMP) + (size_t)(b * 2 + g) * 128 * 64;
    const float* GA = (const float*)(ws + WS_GA); bf16_t* ON = (bf16_t*)(ws + WS_A + A_QA);
    LAS unsigned char* cmpb = lds + NL_CMP;
    LAS float* imp = (LAS float*)(lds + NL_IMP);
    LAS unsigned* selm = (LAS unsigned*)(lds + NL_SEL); LAS unsigned* uni = (LAS unsigned*)(lds + NL_UNI);
    const int hr = wave >> 1, th = wave & 1, head = 4 * g + hr, h = lane >> 5, tl = 32 * th + (lane & 31), t = 64 * tq + tl;
    const size_t row = (size_t)b * SEQ + t;
    LAS const float* tabh = (LAS const float*)(lds + NL_TAB) + 320 * head;
    bf16x8 qf[4];
#pragma unroll
    for (int s = 0; s < 4; ++s) qf[s] = *(const bf16x8*)(QA + row * 512 + head * 64 + 16 * s + 8 * h);
#pragma unroll
    for (int s = 0; s < 4; ++s) asm volatile("" : "+v"(qf[s]));
    const int nct = (4 * tq + 3 > 64) ? 2 : 1;
    for (int i = 0; i < nct; ++i) { tile_st(cmpb + i * KVT, tile_ld(KCM + (size_t)i * 64 * 64, 64, tid), tid); tile_st_v(cmpb + (2 + i) * KVT, tile_ld(VCM + (size_t)i * 64 * 64, 64, tid), tid); }
    if (tid == 0) uni[0] = 0u;
    __syncthreads();
    f32x16 acc0, acc1;
    {
#define CMP_LOGITS(ti) do { qk_tile(p0, p1, cmpb + (ti) * KVT, qf, lane); \
            _Pragma("unroll") for (int r = 0; r < 16; ++r) { const int c = 64 * (ti) + crow(r, h); const int d0 = t - (16 * c + 31), d1 = d0 - 512; \
                p0[r] = (d0 >= 0) ? p0[r] + tabh[min(d0, 127) + 64] : NEG; p1[r] = (d1 >= 0) ? p1[r] + tabh[min(d1, 127) + 64] : NEG; } } while (0)
        f32x16 p0, p1; float mx = NEG, sum = 0.f;
#define CMP_PASS1(ti) do { CMP_LOGITS(ti); float tm = fmaxf(p0[0], p1[0]); _Pragma("unroll") for (int r = 1; r < 16; ++r) tm = fmaxf(tm, fmaxf(p0[r], p1[r])); \
            tm = fmaxf(tm, __shfl_xor(tm, 32)); const float mn = fmaxf(mx, tm); float sacc = 0.f; \
            _Pragma("unroll") for (int r = 0; r < 16; ++r) { sacc += ((p0[r] > -1.0e29f) ? __builtin_amdgcn_exp2f(p0[r] - mn) : 0.f) + ((p1[r] > -1.0e29f) ? __builtin_amdgcn_exp2f(p1[r] - mn) : 0.f); } \
            sum = sum * __builtin_amdgcn_exp2f(mx - mn) + sacc; mx = mn; } while (0)
        CMP_PASS1(0);
        if (nct > 1) CMP_PASS1(1);
        sum += __shfl_xor(sum, 32);
        const float inv = (sum > 0.f) ? 1.0f / sum : 0.f;
        f32x16 z = {}; acc0 = z; acc1 = z;
        LAS float* ip = imp + (hr * 64 + tl) * 33 + h; float carry = 0.f;
#define IMP_TILE(P, T) _Pragma("unroll") for (int qd = 0; qd < 4; ++qd) { const float own = (P[4 * qd] + P[4 * qd + 1]) + (P[4 * qd + 2] + P[4 * qd + 3]); const float rc = __shfl_xor(P[4 * qd + 3], 32); \
              ip[2 * (4 * (T) + qd)] = own + (h ? rc : carry); carry = rc; }
#define CMP_PASS2(ti) do { CMP_LOGITS(ti); \
            _Pragma("unroll") for (int r = 0; r < 16; ++r) { p0[r] = (p0[r] > -1.0e29f) ? __builtin_amdgcn_exp2f(p0[r] - mx) * inv : 0.f; p1[r] = (p1[r] > -1.0e29f) ? __builtin_amdgcn_exp2f(p1[r] - mx) * inv : 0.f; } \
            IMP_TILE(p0, 2 * (ti)) IMP_TILE(p1, 2 * (ti) + 1) \
            bf16x8 pf[4]; pack_p(pf, p0, p1); pv_tile(acc0, acc1, cmpb + (2 + (ti)) * KVT, pf, lane); } while (0)
        CMP_PASS2(0);
        if (nct > 1) CMP_PASS2(1);
#undef CMP_LOGITS
#undef CMP_PASS1
#undef CMP_PASS2
#undef IMP_TILE
        const float g_c = GA[row * 24 + head];
        acc0 *= g_c; acc1 *= g_c;
    }
    __syncthreads();
    if (tid < 64) {
        LAS float* r0 = imp + tid * 33;
        for (int j = 0; j <= tq; ++j) { float s = (r0[j] + imp[(64 + tid) * 33 + j]) + (imp[(128 + tid) * 33 + j] + imp[(192 + tid) * 33 + j]); r0[j] = s; }
        unsigned sel = 1u | (1u << tq); if (tq > 0) sel |= 1u << (tq - 1);
        const int need = 8 - __builtin_popcount(sel);
        for (int it = 0; it < need; ++it) { int best = -1; float bv = -3.0e38f;
            for (int j = 0; j <= tq; ++j) { if (!((sel >> j) & 1u)) { const float v = r0[j]; if (v > bv) { bv = v; best = j; } } }
            if (best >= 0) sel |= 1u << best; }
        selm[tid] = sel; atomicOr((unsigned*)uni, sel);
    }
    __syncthreads();
    const unsigned selbits = selm[tl], utiles = uni[0];
    { FState st; fstate_init(st);
      flash_loop<1>(st, utiles, KS + (size_t)b * SEQ * 128 + 64 * g, VS + (size_t)b * SEQ * 128 + 64 * g, 128, lds, qf, tabh, t, 0, selbits, tq, tid, lane);
      float l = st.l + __shfl_xor(st.l, 32); int l2 = lane; asm volatile("" : "+v"(l2)); const size_t row2 = (size_t)b * SEQ + 64 * tq + 32 * th + (l2 & 31);
      const float g_s = GA[row2 * 24 + 8 + head]; const float sc = (l > 0.f) ? g_s / l : 0.f;
      acc0 += st.o0 * sc; acc1 += st.o1 * sc; }
    { FState st; fstate_init(st);
      const int jlo = max(tq - 8, 0); const unsigned hi = (tq == 31) ? 0xffffffffu : ((1u << (tq + 1)) - 1u); const unsigned wt = hi & ~((1u << jlo) - 1u);
      flash_loop<2>(st, wt, KW + (size_t)b * SEQ * 128 + 64 * g, VW + (size_t)b * SEQ * 128 + 64 * g, 128, lds, qf, tabh, t, 0, 0u, tq, tid, lane);
      float l = st.l + __shfl_xor(st.l, 32); int l2 = lane; asm volatile("" : "+v"(l2)); const size_t row2 = (size_t)b * SEQ + 64 * tq + 32 * th + (l2 & 31);
      const float g_w = GA[row2 * 24 + 16 + head]; const float sc = (l > 0.f) ? g_w / l : 0.f;
      acc0 += st.o0 * sc; acc1 += st.o1 * sc;
      store_ot(ON + row2 * 512 + head * 64, acc0, acc1, l2 >> 5); }
    __syncthreads();
}
#define XB_TMO      128
#define XB_XCNT(j)  (256  + 64 * (j))
#define XB_XSUB(j)  (1280 + 64 * (j))
#define XB_XGEN(j)  (2304 + 64 * (j))
#define XB_TOP      3328
#define XB_TOPGEN   3392
#define XCD_BAR_WORDS 3456
#define XB_SPIN_CAP (1u << 18)

__device__ __forceinline__ unsigned xb_ld(unsigned* p)              { return __hip_atomic_load(p, __ATOMIC_RELAXED, __HIP_MEMORY_SCOPE_AGENT); }
__device__ __forceinline__ unsigned xb_add(unsigned* p, unsigned v) { return __hip_atomic_fetch_add(p, v, __ATOMIC_RELAXED, __HIP_MEMORY_SCOPE_AGENT); }
__device__ __forceinline__ unsigned xb_xcc_id() { return (unsigned)__builtin_amdgcn_s_getreg((3 << 11) | 20) & 0xFu; }
#define XB_SPIN(cond, bar) do { unsigned _sp = 0; while (cond) { __builtin_amdgcn_s_sleep(1); \
    if ((++_sp & 255u) == 0u) { if (xb_ld(&(bar)[XB_TMO])) break; if (_sp > XB_SPIN_CAP) { atomicAdd(&(bar)[XB_TMO], 1u); break; } } } } while (0)

struct XcdBarrier {
    unsigned* bar; unsigned x;
    volatile LAS unsigned* st;
};

__device__ __forceinline__ XcdBarrier xcd_barrier_post(unsigned* bar, volatile LAS unsigned* st, int tid) {
    XcdBarrier b; b.bar = bar; b.x = xb_xcc_id(); b.st = st;
    if (tid == 0) (void)xb_add(&bar[XB_XCNT(b.x)], 1u);
    return b;
}
__device__ __forceinline__ void xcd_barrier_complete(unsigned* bar, unsigned x, unsigned& nloc, unsigned& nx) {
    const unsigned G = gridDim.x;
    unsigned sum, cnt, mine, sp = 0u;
    for (;;) {
        sum = 0u; cnt = 0u; mine = 0u;
#pragma unroll
        for (unsigned j = 0; j < 16; ++j) { const unsigned c = xb_ld(&bar[XB_XCNT(j)]); sum += c; cnt += (c > 0u) ? 1u : 0u; mine = (j == x) ? c : mine; }
        if (sum == G) break;
        __builtin_amdgcn_s_sleep(1);
        if ((++sp & 255u) == 0u) { if (xb_ld(&bar[XB_TMO])) break; if (sp > XB_SPIN_CAP) { atomicAdd(&bar[XB_TMO], 1u); break; } }
    }
    nloc = mine > 0u ? mine : 1u; nx = cnt > 0u ? cnt : 1u;
}

__device__ __forceinline__ void xcd_barrier(const XcdBarrier& b, int tid) {
    asm volatile("s_waitcnt vmcnt(0)" ::: "memory");
    __syncthreads();
    if (tid == 0) {
        unsigned* bar = b.bar;
        __builtin_amdgcn_s_waitcnt(0);
        unsigned nloc = b.st[0], nx = b.st[1];
        if (nloc == 0u) { xcd_barrier_complete(bar, b.x, nloc, nx); b.st[0] = nloc; b.st[1] = nx; }
        const unsigned old = xb_add(&bar[XB_XSUB(b.x)], 1u);
        const unsigned gen = old / nloc;
        if (old + 1u == (gen + 1u) * nloc) {
            __builtin_amdgcn_fence(__ATOMIC_RELEASE, "agent");
            asm volatile("s_waitcnt vmcnt(0)" ::: "memory");
            const unsigned og = xb_add(&bar[XB_TOP], 1u);
            const unsigned tg = og / nx;
            if (og + 1u == (tg + 1u) * nx) xb_add(&bar[XB_TOPGEN], 1u);
            else XB_SPIN(xb_ld(&bar[XB_TOPGEN]) == tg, bar);
            __builtin_amdgcn_fence(__ATOMIC_ACQUIRE, "agent");
            xb_add(&bar[XB_XGEN(b.x)], 1u);
            asm volatile("s_waitcnt vmcnt(0)" ::: "memory");
        } else {
            XB_SPIN(xb_ld(&bar[XB_XGEN(b.x)]) == gen, bar);
            __builtin_amdgcn_fence(__ATOMIC_ACQUIRE, "agent");
            asm volatile("s_waitcnt vmcnt(0)" ::: "memory");
        }
    }
    __syncthreads();
}

constexpr int NPHASE = 11;
#ifndef PHMASK
#define PHMASK 0xfff
#endif
#ifndef MK_MULTI_LAUNCH
#define MK_MULTI_LAUNCH 0
#endif
__global__ void __launch_bounds__(NTHREADS, 2) fwd_kernel(Args a) {
    extern __shared__ __attribute__((aligned(16))) unsigned char lds_raw[];
    LAS unsigned char* lds = (LAS unsigned char*)lds_raw;
    const int G = gridDim.x, bx = blockIdx.x, vcu = (G % 8 == 0) ? (bx % 8) * (G / 8) + bx / 8 : bx;
    unsigned char* const ws = a.ws;
#define P_XB ((bf16_t*)(ws + WS_XB))
#define P_HB ((bf16_t*)(ws + WS_A))
#define P_MERGED ((bf16_t*)(ws + WS_A + A_KB))
#define P_SSQ ((float*)(ws + WS_SSQ))
#define P_GM ((bf16_t*)(ws + WS_A + A_GM))
    const int lo = a.ph_lo, hi = a.ph_hi;
    const int wave_s = __builtin_amdgcn_readfirstlane(threadIdx.x >> 6);
#define MYTID() (wave_s * 64 + (int)__builtin_amdgcn_mbcnt_hi(~0u, __builtin_amdgcn_mbcnt_lo(~0u, 0u)))
#define IN(k) (lo <= (k) && (k) < hi)

#define GRID_BARRIER() do { XcdBarrier bar_; bar_.bar = (unsigned*)ws; bar_.x = xb_xcc_id(); bar_.st = (volatile LAS unsigned*)(lds + 131072); xcd_barrier(bar_, MYTID()); } while (0)
#define SYNC_AFTER(k) do { if (IN(k) && IN((k) + 1)) GRID_BARRIER(); } while (0)
#define OPAQUE_TID() int tid = MYTID(); asm volatile("" : "+v"(tid)); const int lane = tid & 63, wave = __builtin_amdgcn_readfirstlane(tid >> 6); (void)lane; (void)wave
#define GEMM_SWIGLU(k, WOFF) if (IN(k)) { pg8::Gemm g{P_XB, (const bf16_t*)(ws + (WOFF)), MTOK, NUP, DM}; pg8::StaticOrder S; S.init(MTOK, NUP, G, bx); pg8::EpiSwiGLU E{P_HB, DFF, P_SSQ}; \
        pg8::gemm_phase<pg8::EpiSwiGLU, pg8::StaticOrder, true, true>(lds, g, S, E, MYTID()); }
#define GEMM_RESID(k, APTR, WOFF, KDIM, BF, BB, OF, OB, ALPHA, SSQP) if (IN(k)) { pg8::Gemm g{(APTR), (const bf16_t*)(ws + (WOFF)), MTOK, DM, (KDIM)}; pg8::StaticOrder S; S.init(MTOK, DM, G, bx); \
        pg8::EpiResid E{(BF), (BB), (OF), (OB), (ALPHA), (SSQP)}; pg8::gemm_phase<pg8::EpiResid, pg8::StaticOrder, true, true>(lds, g, S, E, MYTID()); }
#define GEMM_GATE(k, APTR, WOFF, GOFF, FIRST) if (IN(k)) { pg8::Gemm g{(APTR), (const bf16_t*)(ws + (WOFF)), MTOK, DM, 512}; pg8::StaticOrder S; S.init(MTOK, DM, G, bx); \
        pg8::EpiGate E{P_MERGED, P_GM, (GOFF), (FIRST)}; pg8::gemm_phase<pg8::EpiGate, pg8::StaticOrder, true, true>(lds, g, S, E, MYTID()); }
    { volatile LAS unsigned* stw = (volatile LAS unsigned*)(lds + 131072); if (threadIdx.x == 0) { stw[0] = 0u; stw[1] = 0u; } __syncthreads(); }
    (void)xcd_barrier_post((unsigned*)ws, (volatile LAS unsigned*)(lds + 131072), (int)threadIdx.x);
    if (IN(0)) { OPAQUE_TID(); prep_phase(a, lds, vcu, G, wave, lane); }
    SYNC_AFTER(0);
    GEMM_SWIGLU(1, WS_WUP1)
    SYNC_AFTER(1);
    GEMM_RESID(2, P_HB, WS_WDN1, DFF, a.in[0], (const bf16_t*)nullptr, (float*)nullptr, P_XB, 0.5f, P_SSQ)
    SYNC_AFTER(2);
    if (IN(3)) {
        pg8::Gemm g{P_XB, (const bf16_t*)(ws + WS_WIN), MTOK, NIN, DM}; pg8::StaticOrder S; S.init(MTOK, NIN, G, bx);
        pg8::EpiProj E; unsigned char* A = ws + WS_A;
        E.P.QA = (bf16_t*)(A + A_QA); E.P.KC = (bf16_t*)(A + A_KC); E.P.VC = (bf16_t*)(A + A_VC); E.P.KS = (bf16_t*)(A + A_KS); E.P.VS = (bf16_t*)(A + A_VS); E.P.KW = (bf16_t*)(A + A_KW); E.P.VW = (bf16_t*)(A + A_VW);
        E.P.QB = (bf16_t*)(A + A_QB); E.P.KB = (bf16_t*)(A + A_KB); E.P.VB = (bf16_t*)(A + A_VB); E.P.GM = P_GM; E.P.GA = (float*)(ws + WS_GA); E.P.LF = (float*)(ws + WS_LF);
        E.ssq = P_SSQ; E.nsa_q_gain = a.in[7]; E.nsa_k_gain = a.in[8]; E.fox_q_gain = a.in[9]; E.fox_k_gain = a.in[10]; E.b_forget = a.in[6];
        pg8::gemm_phase<pg8::EpiProj, pg8::StaticOrder, true, true>(lds, g, S, E, MYTID());
    }
    SYNC_AFTER(3);
    if (IN(4)) { OPAQUE_TID();
        for (int U = vcu; U < 256; U += G) { int tu = tid; asm volatile("" : "+v"(tu)); compress_unit(U, a, lds, tu, wave, tu & 63); }
        for (int U = vcu; U < 1024; U += G) { const int i = U >> 8, v = U & 255, bh = v >> 1, half = v & 1; const int qb = (i == 0) ? half : (i == 1) ? 7 - half : (i == 2) ? 2 + half : 5 - half;
            int tu = tid; asm volatile("" : "+v"(tu)); fox_unit(bh >> 3, bh & 7, qb, a, lds, tu, wave, tu & 63); }
    }
    SYNC_AFTER(4);
    if (IN(5)) { OPAQUE_TID();
        { const float* TAB = (const float*)(ws + WS_TAB); LAS float* tl = (LAS float*)(lds + NL_TAB); for (int i = tid; i < 8 * 320; i += NTHREADS) { const int hd = i / 320, d = i % 320 - 64; tl[i] = TAB[hd * 128 + min(max(d, 0), 127)]; } }
        __syncthreads();
        for (int U = vcu; U < 1024; U += G) { const int i = U >> 8, v = U & 255, bg = v >> 3, s = v & 7; const int tq = (i == 0) ? s : (i == 1) ? 15 - s : (i == 2) ? 16 + s : 31 - s;
            int tu = tid; asm volatile("" : "+v"(tu)); nsa_unit(bg >> 1, bg & 1, tq, a, lds, tu, wave, tu & 63); }
    }
    SYNC_AFTER(5);
    GEMM_GATE(6, (bf16_t*)(ws + WS_A + A_QA), WS_WON, 0, true)
    GEMM_GATE(7, (bf16_t*)(ws + WS_A + A_QB), WS_WOF, 1024, false)
    SYNC_AFTER(7);
    GEMM_RESID(8, P_MERGED, WS_WOUT, DM, (const float*)nullptr, P_XB, (float*)nullptr, P_XB, 1.0f, P_SSQ)
    SYNC_AFTER(8);
    GEMM_SWIGLU(9, WS_WUP2)
    SYNC_AFTER(9);
    GEMM_RESID(10, P_HB, WS_WDN2, DFF, (const float*)nullptr, P_XB, a.out, (bf16_t*)nullptr, 0.5f, (float*)nullptr)
}

extern "C" void kernel_launch(void* const* d_in, const int* in_sizes, int n_in, void* d_out, int out_size, void* d_ws, size_t ws_size, hipStream_t stream) {
    static int grid = 0;
    if (grid == 0) {
        if (n_in != 24 || in_sizes[0] != MTOK * DM || out_size != MTOK * DM || ws_size < WS_END) { fprintf(stderr, "kernel_launch: unexpected shapes (n_in %d, in0 %d, out %d, ws %zu < %zu)\n", n_in, n_in > 0 ? in_sizes[0] : -1, out_size, ws_size, (size_t)WS_END); grid = -1; return; }
        int dev = 0, cus = 0, per_cu = 0;
        if (hipGetDevice(&dev) != hipSuccess || hipDeviceGetAttribute(&cus, hipDeviceAttributeMultiprocessorCount, dev) != hipSuccess) { grid = -1; return; }
        if (hipFuncSetAttribute((const void*)fwd_kernel, hipFuncAttributeMaxDynamicSharedMemorySize, LDS_BYTES) != hipSuccess) { fprintf(stderr, "kernel_launch: hipFuncSetAttribute failed\n"); grid = -1; return; }
        if (hipOccupancyMaxActiveBlocksPerMultiprocessor(&per_cu, (const void*)fwd_kernel, NTHREADS, LDS_BYTES) != hipSuccess || per_cu < 1) { fprintf(stderr, "kernel_launch: occupancy query reports %d blocks per CU\n", per_cu); (void)hipGetLastError(); grid = -1; return; }
        grid = cus;
    }
    if (grid < 0) return;
    if (hipMemsetAsync(d_ws, 0, 65536, stream) != hipSuccess) { fprintf(stderr, "kernel_launch: memset of the control words failed\n"); return; }
    Args a{};
    for (int i = 0; i < 24; ++i) a.in[i] = (const float*)d_in[i];
    a.out = (float*)d_out; a.ws = (unsigned char*)d_ws;
#if MK_MULTI_LAUNCH
    for (int ph = 0; ph < NPHASE; ++ph) { a.ph_lo = ph; a.ph_hi = ph + 1; hipLaunchKernelGGL(fwd_kernel, dim3(grid), dim3(NTHREADS), LDS_BYTES, stream, a); }
#else
    a.ph_lo = 0; a.ph_hi = NPHASE;
    void* args[] = {&a};
    const hipError_t e = hipLaunchCooperativeKernel((const void*)fwd_kernel, dim3(grid), dim3(NTHREADS), args, LDS_BYTES, stream);
    if (e != hipSuccess) fprintf(stderr, "kernel_launch: cooperative launch failed: %s (grid %d)\n", hipGetErrorString(e), grid);
#endif
}
```
